# Optimizing an MI355X kernel written in HIP

```python
import math
import jax
import jax.numpy as jnp
from jax import lax
import numpy as np

D_MODEL = 2048
BATCH = 1
SEQ = 8192
DEPTH = 2

CHUNK = 64
Q_BLOCK = 128
EPS = 1e-6
SB_HEADS = 4
HEAD_DIM = 128
SB_WIDTH = SB_HEADS * HEAD_DIM
FOX_HEADS = 4
FOX_WIDTH = FOX_HEADS * HEAD_DIM
SSM_HEAD_DIM = 64
SSM_HEADS = 16
SSM_INNER = SSM_HEADS * SSM_HEAD_DIM
SSM_GROUPS = 2
SSM_STATE = 128
CONV_WIDTH = 4
SSM_CONV_DIM = SSM_INNER + 2 * SSM_GROUPS * SSM_STATE
N_BRANCH = 3
IN_PROJ_SIZES = (SB_WIDTH, SB_WIDTH, SB_WIDTH,
                 FOX_WIDTH, FOX_WIDTH, FOX_WIDTH, FOX_HEADS,
                 SSM_INNER, SSM_CONV_DIM, SSM_HEADS,
                 N_BRANCH * D_MODEL)
IN_PROJ_WIDTH = sum(IN_PROJ_SIZES)
N_EXPERTS = 16
N_EXPERT_GROUPS = 4
EXPERTS_PER_GROUP = N_EXPERTS // N_EXPERT_GROUPS
TOPK_GROUPS = 1
TOP_K = 2
D_FF_EXPERT = 1024

kernel_name = 'hybrid_sb_fox_ssd_moe_encoder'


def rms_norm(x, gain):
    xf = x.astype(jnp.float32)
    y = xf * lax.rsqrt(jnp.mean(xf * xf, axis=-1, keepdims=True) + EPS)
    return (y * gain.astype(jnp.float32)).astype(x.dtype)


def split_heads(u, n_heads):
    b, s, _ = u.shape
    return u.reshape(b, s, n_heads, -1)


def query_blocks(u):
    b, s = u.shape[:2]
    u = u.reshape((b, s // Q_BLOCK, Q_BLOCK) + u.shape[2:])
    return jnp.moveaxis(u, 1, 0)


def merge_query_blocks(u):
    u = jnp.moveaxis(u, 0, 1)
    return u.reshape((u.shape[0], -1) + u.shape[3:])


def stick_breaking_attention(q, k, v):
    s_len, d = q.shape[1], q.shape[-1]
    scale = d ** -0.5
    k_pos = jnp.arange(s_len)

    def block(args):
        q_blk, blk = args
        q_pos = blk * Q_BLOCK + jnp.arange(Q_BLOCK)
        z = jnp.einsum('bqhd,bkhd->bhqk', q_blk, k).astype(jnp.float32) * scale
        past = k_pos[None, :] < q_pos[:, None]
        log_keep = jnp.where(past, jax.nn.log_sigmoid(-z), 0.0)
        suffix = lax.cumsum(log_keep, axis=3, reverse=True)
        between = jnp.concatenate([suffix[..., 1:], jnp.zeros_like(suffix[..., :1])], axis=-1)
        weight = jnp.where(past, jnp.exp(jax.nn.log_sigmoid(z) + between), 0.0)
        return jnp.einsum('bhqk,bkhd->bqhd', weight.astype(v.dtype), v)

    n_blk = s_len // Q_BLOCK
    out = lax.map(block, (query_blocks(q), jnp.arange(n_blk)))
    return merge_query_blocks(out)


def forgetting_attention(q, k, v, log_f):
    s_len, d = q.shape[1], q.shape[-1]
    scale = d ** -0.5
    k_pos = jnp.arange(s_len)
    f_cum = lax.cumsum(log_f.astype(jnp.float32), axis=1)
    f_key = jnp.swapaxes(f_cum, 1, 2)[:, :, None, :]

    def block(args):
        q_blk, fq_blk, blk = args
        q_pos = blk * Q_BLOCK + jnp.arange(Q_BLOCK)
        logits = (jnp.einsum('bqhd,bkhd->bhqk', q_blk, k).astype(jnp.float32) * scale
                  + jnp.swapaxes(fq_blk, 1, 2)[..., None] - f_key)
        mask = k_pos[None, :] <= q_pos[:, None]
        p = jax.nn.softmax(jnp.where(mask, logits, -jnp.inf), axis=-1)
        return jnp.einsum('bhqk,bkhd->bqhd', p.astype(v.dtype), v)

    n_blk = s_len // Q_BLOCK
    out = lax.map(block, (query_blocks(q), query_blocks(f_cum), jnp.arange(n_blk)))
    return merge_query_blocks(out)


def causal_depthwise_conv(u, w, bias):
    width, ch = w.shape
    out = lax.conv_general_dilated(u, w[:, None, :], window_strides=(1,),
                                   padding=[(width - 1, 0)],
                                   dimension_numbers=('NWC', 'WIO', 'NWC'),
                                   feature_group_count=ch)
    return out + bias


def ssd_chunked(x, dt, a, b_mat, c_mat):
    bsz, s_len, n_h, p = x.shape
    g, n = b_mat.shape[-2:]
    hg = n_h // g
    nc = s_len // CHUNK
    xc = (x * dt[..., None]).reshape(bsz, nc, CHUNK, g, hg, p)
    log_a = (dt * a).reshape(bsz, nc, CHUNK, g, hg)
    bc = b_mat.reshape(bsz, nc, CHUNK, g, n)
    cc = c_mat.reshape(bsz, nc, CHUNK, g, n)
    a_cum = lax.cumsum(log_a, axis=2)
    idx = jnp.arange(CHUNK)
    causal = (idx[:, None] >= idx[None, :])[:, :, None, None]
    seg = a_cum[:, :, :, None] - a_cum[:, :, None, :]
    decay = jnp.exp(jnp.where(causal, seg, -jnp.inf))
    cb = jnp.einsum('bclgn,bcsgn->bclsg', cc, bc)
    y_diag = jnp.einsum('bclsg,bclsgh,bcsghp->bclghp', cb, decay, xc)
    to_end = jnp.exp(a_cum[:, :, -1:] - a_cum)
    states = jnp.einsum('bclgn,bclgh,bclghp->bcghpn', bc, to_end, xc)
    chunk_decay = jnp.exp(a_cum[:, :, -1])

    def step(h, inp):
        st, dec = inp
        return h * dec[..., None, None] + st, h

    h0 = jnp.zeros_like(states[:, 0])
    _, h_in = lax.scan(step, h0, (jnp.moveaxis(states, 1, 0), jnp.moveaxis(chunk_decay, 1, 0)))
    h_in = jnp.moveaxis(h_in, 0, 1)
    y_off = jnp.einsum('bclgn,bcghpn,bclgh->bclghp', cc, h_in, jnp.exp(a_cum))
    return (y_diag + y_off).reshape(bsz, s_len, n_h, p)


def mamba2_mixer(z, xbc, dt_raw, conv_w, conv_b, dt_bias, a_log, d_skip, g_norm):
    b, s, _ = z.shape
    xbc = jax.nn.silu(causal_depthwise_conv(xbc, conv_w, conv_b))
    xs, b_mat, c_mat = jnp.split(xbc, [SSM_INNER, SSM_INNER + SSM_GROUPS * SSM_STATE], axis=-1)
    x_h = xs.reshape(b, s, SSM_HEADS, SSM_HEAD_DIM)
    dt = jax.nn.softplus((dt_raw + dt_bias).astype(jnp.float32))
    a = -jnp.exp(a_log.astype(jnp.float32))
    y = ssd_chunked(x_h, dt, a,
                    b_mat.reshape(b, s, SSM_GROUPS, SSM_STATE),
                    c_mat.reshape(b, s, SSM_GROUPS, SSM_STATE))
    y = y + d_skip.astype(jnp.float32)[:, None] * x_h
    y = y.reshape(b, s, SSM_INNER).astype(z.dtype)
    return rms_norm(y * jax.nn.silu(z), g_norm)


def grouped_moe(h, w_router, b_router, w_gate, w_up, w_down):
    b, s, d = h.shape
    t = h.reshape(b * s, d)
    n_tok = t.shape[0]
    affinity = jax.nn.sigmoid((t @ w_router).astype(jnp.float32))
    sel = (affinity + b_router.astype(jnp.float32)).reshape(n_tok, N_EXPERT_GROUPS, EXPERTS_PER_GROUP)
    group_score = lax.top_k(sel, 2)[0].sum(-1)
    _, g_idx = lax.top_k(group_score, TOPK_GROUPS)
    group_mask = jax.nn.one_hot(g_idx, N_EXPERT_GROUPS, dtype=jnp.float32).sum(1) > 0
    masked = jnp.where(group_mask[:, :, None], sel, -jnp.inf).reshape(n_tok, N_EXPERTS)
    _, e_idx = lax.top_k(masked, TOP_K)
    w_sel = jnp.take_along_axis(affinity, e_idx, axis=-1)
    w_sel = w_sel / jnp.sum(w_sel, axis=-1, keepdims=True)
    combine = jnp.sum(jax.nn.one_hot(e_idx, N_EXPERTS, dtype=jnp.float32) * w_sel[..., None], axis=1)
    combine = combine.astype(t.dtype)
    y = jnp.zeros_like(t)
    for e in range(N_EXPERTS):
        act = jax.nn.silu(t @ w_gate[e]) * (t @ w_up[e])
        y = y + combine[:, e:e + 1] * (act @ w_down[e])
    return y.reshape(b, s, d)


def setup_inputs(seed: int = 0) -> dict:
    key = jax.random.key(seed)
    ks = iter(jax.random.split(key, 40))
    L, D, E, F = DEPTH, D_MODEL, N_EXPERTS, D_FF_EXPERT

    def nrm(shape, scale):
        return jax.random.normal(next(ks), shape, jnp.float32) * scale

    x = nrm((BATCH, SEQ, D), 1.0)
    c = nrm((BATCH, D), 1.0)
    w_ada = nrm((L, D, 6 * D), 0.5 * D ** -0.5)
    b_ada = nrm((L, 6 * D), 0.02)
    g_norm_mix = 1.0 + nrm((L, D), 0.02)
    w_in = nrm((L, D, IN_PROJ_WIDTH), D ** -0.5)
    b_fgate = 3.0 + nrm((L, FOX_HEADS), 0.5)
    g_q_fox = 1.0 + nrm((L, HEAD_DIM), 0.02)
    g_k_fox = 1.0 + nrm((L, HEAD_DIM), 0.02)
    conv_w = nrm((L, CONV_WIDTH, SSM_CONV_DIM), CONV_WIDTH ** -0.5)
    conv_b = nrm((L, SSM_CONV_DIM), 0.02)
    dt0 = jnp.exp(jax.random.uniform(next(ks), (L, SSM_HEADS), jnp.float32,
                                     math.log(1e-3), math.log(1e-1)))
    dt_bias = dt0 + jnp.log(-jnp.expm1(-dt0))
    a_log = jnp.log(jax.random.uniform(next(ks), (L, SSM_HEADS), jnp.float32, 1.0, 16.0))
    d_skip = 1.0 + nrm((L, SSM_HEADS), 0.02)
    g_ssm_norm = 1.0 + nrm((L, SSM_INNER), 0.02)
    w_branch_sb = nrm((L, SB_WIDTH, D), SB_WIDTH ** -0.5)
    w_branch_fox = nrm((L, FOX_WIDTH, D), FOX_WIDTH ** -0.5)
    w_branch_ssm = nrm((L, SSM_INNER, D), SSM_INNER ** -0.5)
    w_out = nrm((L, D, D), D ** -0.5)
    g_norm_ffn = 1.0 + nrm((L, D), 0.02)
    w_router = nrm((D, E), D ** -0.5)
    b_router = nrm((E,), 0.01)
    w_e_gate = nrm((L, E, D, F), D ** -0.5)
    w_e_up = nrm((L, E, D, F), D ** -0.5)
    w_e_down = nrm((L, E, F, D), F ** -0.5)
    return {'x': x, 'c': c, 'w_ada': w_ada, 'b_ada': b_ada, 'g_norm_mix': g_norm_mix,
            'w_in': w_in, 'b_fgate': b_fgate, 'g_q_fox': g_q_fox, 'g_k_fox': g_k_fox,
            'conv_w': conv_w, 'conv_b': conv_b, 'dt_bias': dt_bias, 'a_log': a_log,
            'd_skip': d_skip, 'g_ssm_norm': g_ssm_norm, 'w_branch_sb': w_branch_sb,
            'w_branch_fox': w_branch_fox, 'w_branch_ssm': w_branch_ssm, 'w_out': w_out,
            'g_norm_ffn': g_norm_ffn, 'w_router': w_router, 'b_router': b_router,
            'w_e_gate': w_e_gate, 'w_e_up': w_e_up, 'w_e_down': w_e_down}


def reference(x, c, w_ada, b_ada, g_norm_mix, w_in, b_fgate, g_q_fox, g_k_fox,
              conv_w, conv_b, dt_bias, a_log, d_skip, g_ssm_norm, w_branch_sb,
              w_branch_fox, w_branch_ssm, w_out, g_norm_ffn, w_router, b_router,
              w_e_gate, w_e_up, w_e_down):
    b, s, d = x.shape
    offsets = []
    acc = 0
    for size in IN_PROJ_SIZES[:-1]:
        acc += size
        offsets.append(acc)
    cond = jax.nn.silu(c)
    for layer in range(DEPTH):
        mod = (cond @ w_ada[layer] + b_ada[layer])[:, None, :]
        shift_m, scale_m, gate_m, shift_f, scale_f, gate_f = jnp.split(mod, 6, axis=-1)

        h = rms_norm(x, g_norm_mix[layer]) * (1.0 + scale_m) + shift_m
        (sb_q, sb_k, sb_v, fx_q, fx_k, fx_v, fx_f,
         ssm_z, ssm_xbc, ssm_dt, gate_logits) = jnp.split(h @ w_in[layer], offsets, axis=-1)

        o_sb = stick_breaking_attention(split_heads(sb_q, SB_HEADS), split_heads(sb_k, SB_HEADS),
                                        split_heads(sb_v, SB_HEADS)).reshape(b, s, SB_WIDTH)
        log_f = jax.nn.log_sigmoid((fx_f + b_fgate[layer]).astype(jnp.float32))
        o_fox = forgetting_attention(rms_norm(split_heads(fx_q, FOX_HEADS), g_q_fox[layer]),
                                     rms_norm(split_heads(fx_k, FOX_HEADS), g_k_fox[layer]),
                                     split_heads(fx_v, FOX_HEADS), log_f).reshape(b, s, FOX_WIDTH)
        o_ssm = mamba2_mixer(ssm_z, ssm_xbc, ssm_dt, conv_w[layer], conv_b[layer],
                             dt_bias[layer], a_log[layer], d_skip[layer], g_ssm_norm[layer])

        gates = jax.nn.sigmoid(gate_logits).reshape(b, s, N_BRANCH, d)
        merged = (gates[:, :, 0] * (o_sb @ w_branch_sb[layer])
                  + gates[:, :, 1] * (o_fox @ w_branch_fox[layer])
                  + gates[:, :, 2] * (o_ssm @ w_branch_ssm[layer]))
        x = x + gate_m * (merged @ w_out[layer])

        h = rms_norm(x, g_norm_ffn[layer]) * (1.0 + scale_f) + shift_f
        x = x + gate_f * grouped_moe(h, w_router, b_router, w_e_gate[layer],
                                     w_e_up[layer], w_e_down[layer])
    return x
```

```cpp
#include <hip/hip_runtime.h>
#include <stdint.h>
#include <stddef.h>


namespace fx {
#define FX_LAS __attribute__((address_space(3)))
#define FX_CAS __attribute__((address_space(4)))
typedef unsigned short bf16_t;
typedef short bf16x8 __attribute__((ext_vector_type(8)));
typedef short s16x4 __attribute__((ext_vector_type(4)));
typedef float f32x4 __attribute__((ext_vector_type(4)));
typedef float f32x2 __attribute__((ext_vector_type(2)));
typedef unsigned u32x4 __attribute__((ext_vector_type(4)));
typedef unsigned u32x2 __attribute__((ext_vector_type(2)));

constexpr int S = 8192, D = 2048, NP = 11796, NPAD = 12032, NE = 16, FF = 1024;
constexpr int C_SBQ = 0, C_SBK = 512, C_SBV = 1024, C_FXQ = 1536, C_FXK = 2048, C_FXV = 2560, C_Z = 3072, C_XBC = 4096, C_GATE = 5632, C_SMALL = 11776;
constexpr float CQK = 0.08838834764831845f * 1.4426950408889634f;
constexpr float LOG2E = 1.4426950408889634f;
constexpr int NWAVES = 8, NTHR = 512;
constexpr int SLOTCAP = 20480;
constexpr int LDS_BYTES = 147456;
constexpr int LDS_MISC = 139264;

typedef __bf16 fx_bf2 __attribute__((ext_vector_type(2))); typedef float fx_f2 __attribute__((ext_vector_type(2)));
__device__ __forceinline__ unsigned cvt_pk_bf16(float lo, float hi) { const fx_f2 v = {lo, hi}; const fx_bf2 b = __builtin_convertvector(v, fx_bf2); return __builtin_bit_cast(unsigned, b); }
__device__ __forceinline__ float bf2f(unsigned short b) { return __uint_as_float(((unsigned)b) << 16); }
__device__ __forceinline__ float bflo(unsigned w) { return __uint_as_float(w << 16); }
__device__ __forceinline__ float bfhi(unsigned w) { return __uint_as_float(w & 0xffff0000u); }
__device__ __forceinline__ float fast_exp2(float x) { return __builtin_amdgcn_exp2f(x); }
__device__ __forceinline__ float fast_rcp(float x) { return __builtin_amdgcn_rcpf(x); }
__device__ __forceinline__ float sigmoid_f(float x) { return fast_rcp(1.0f + fast_exp2(-x * LOG2E)); }
__device__ __forceinline__ float silu_f(float x) { return x * sigmoid_f(x); }
__device__ __forceinline__ int fx_lane() { int l = (int)__builtin_amdgcn_mbcnt_hi(~0u, __builtin_amdgcn_mbcnt_lo(~0u, 0u)); asm volatile("" : "+v"(l)); return l; }
__device__ __forceinline__ float shfl_idx(float v, int src) { return __int_as_float(__builtin_amdgcn_ds_bpermute(src << 2, __float_as_int(v))); }
__device__ __forceinline__ float shfl_xorl(float v, int m, int lane) { return shfl_idx(v, lane ^ m); }
__device__ __forceinline__ float shfl_upl(float v, int d, int lane) { return shfl_idx(v, lane >= d ? lane - d : lane); }
__device__ __forceinline__ float wave_sum(float v) {
    const int lane = fx_lane();
#pragma unroll
    for (int o = 1; o < 64; o <<= 1) v += shfl_xorl(v, o, lane);
    return v;
}

#define XB_TMO      128
#define XB_XCNT(j)  (256  + 64 * (j))
#define XB_XSUB(j)  (1280 + 64 * (j))
#define XB_XGEN(j)  (2304 + 64 * (j))
#define XB_TOP      3328
#define XB_TOPGEN   3392
#define XCD_BAR_WORDS 3456
#define XB_SPIN_CAP (1u << 18)
__device__ __forceinline__ unsigned xb_ld(unsigned* p)              { return __hip_atomic_load(p, __ATOMIC_RELAXED, __HIP_MEMORY_SCOPE_AGENT); }
__device__ __forceinline__ unsigned xb_add(unsigned* p, unsigned v) { return __hip_atomic_fetch_add(p, v, __ATOMIC_RELAXED, __HIP_MEMORY_SCOPE_AGENT); }
__device__ __forceinline__ unsigned xb_xcc_id() { return (unsigned)__builtin_amdgcn_s_getreg((3 << 11) | 20) & 0xFu; }
#define XB_SPIN(cond, bar) do { unsigned _sp = 0; while (cond) { __builtin_amdgcn_s_sleep(1); \
    if ((++_sp & 255u) == 0u) { if (xb_ld(&(bar)[XB_TMO])) break; if (_sp > XB_SPIN_CAP) { atomicAdd(&(bar)[XB_TMO], 1u); break; } } } } while (0)
struct XcdBarrier { unsigned* bar; unsigned x; volatile FX_LAS unsigned* st; int wave; };
__device__ __forceinline__ bool xb_leader(int wave) { return wave == 0 && __builtin_amdgcn_mbcnt_hi(~0u, __builtin_amdgcn_mbcnt_lo(~0u, 0u)) == 0u; }
__device__ __forceinline__ XcdBarrier xcd_barrier_post(unsigned* bar, volatile FX_LAS unsigned* st, int wave) {
    XcdBarrier b; b.bar = bar; b.x = xb_xcc_id(); b.st = st; b.wave = wave;
    if (xb_leader(wave)) (void)xb_add(&bar[XB_XCNT(b.x)], 1u);
    return b;
}
__device__ __forceinline__ void xcd_barrier_complete(unsigned* bar, unsigned x, unsigned& nloc, unsigned& nx) {
    const unsigned G = gridDim.x * gridDim.y * gridDim.z;
    unsigned sum, cnt, mine, sp = 0u;
    for (;;) {
        sum = 0u; cnt = 0u; mine = 0u;
#pragma unroll
        for (unsigned j = 0; j < 16; ++j) { const unsigned c = xb_ld(&bar[XB_XCNT(j)]); sum += c; cnt += (c > 0u) ? 1u : 0u; mine = (j == x) ? c : mine; }
        if (sum == G) break;
        __builtin_amdgcn_s_sleep(1);
        if ((++sp & 255u) == 0u) { if (xb_ld(&bar[XB_TMO])) break; if (sp > XB_SPIN_CAP) { atomicAdd(&bar[XB_TMO], 1u); break; } }
    }
    nloc = mine > 0u ? mine : 1u; nx = cnt > 0u ? cnt : 1u;
}
__device__ __forceinline__ void xcd_barrier(const XcdBarrier& b) {
    asm volatile("s_waitcnt vmcnt(0)" ::: "memory");
    __syncthreads();
    if (xb_leader(b.wave)) {
        unsigned* bar = b.bar; asm volatile("" : "+s"(bar));
        __builtin_amdgcn_s_waitcnt(0);
        unsigned nloc = b.st[0], nx = b.st[1];
        if (nloc == 0u) { xcd_barrier_complete(bar, b.x, nloc, nx); b.st[0] = nloc; b.st[1] = nx; }
        const unsigned old = xb_add(&bar[XB_XSUB(b.x)], 1u);
        const unsigned gen = old / nloc;
        if (old + 1u == (gen + 1u) * nloc) {
            __builtin_amdgcn_fence(__ATOMIC_RELEASE, "agent");
            asm volatile("s_waitcnt vmcnt(0)" ::: "memory");
            const unsigned og = xb_add(&bar[XB_TOP], 1u);
            const unsigned tg = og / nx;
            if (og + 1u == (tg + 1u) * nx) xb_add(&bar[XB_TOPGEN], 1u);
            else XB_SPIN(xb_ld(&bar[XB_TOPGEN]) == tg, bar);
            __builtin_amdgcn_fence(__ATOMIC_ACQUIRE, "agent");
            xb_add(&bar[XB_XGEN(b.x)], 1u);
            asm volatile("s_waitcnt vmcnt(0)" ::: "memory");
        } else {
            XB_SPIN(xb_ld(&bar[XB_XGEN(b.x)]) == gen, bar);
            __builtin_amdgcn_fence(__ATOMIC_ACQUIRE, "agent");
            asm volatile("s_waitcnt vmcnt(0)" ::: "memory");
        }
    }
    __syncthreads();
}

struct Args {
    const float* in[25];
    float* out;
    unsigned* ctl;
    float* mod;
    bf16_t *w_in_t, *w_br_t, *w_out_t, *w_gu_t, *w_d_t;
    bf16_t* act;
    float* small;
    bf16_t* hb;
    bf16_t* xbuf;
    const float* xin;
    bf16_t *osb, *ofox, *ossm;
    bf16_t* merged;
    float* ft;
    bf16_t* states;
    bf16_t* hin;
    bf16_t* y1;
    bf16_t* cc;
    float* acum;
    float* cdec;
    int* eidx; float* wsel; int* slot; int* list; int* cntb; int* tbase;
    float* c0;
    bf16_t* actb;
    bf16_t* ybuf;
    int layer_lo, layer_hi, ph_lo, ph_hi;
};

constexpr int BM = 256, BK = 64, HALF = 128, HTB = HALF * BK * 2, STAGE_BYTES = 8 * HTB, NXCD = 8, WGM = 8;
__host__ __device__ __forceinline__ int lds_byte(int r, int c) { const int st = (r >> 4) * 2 + (c >> 5), rr = r & 15, cc = c & 31, ob = rr * 64 + cc * 2; return st * 1024 + (ob ^ (((ob >> 9) & 1) << 5)); }
__host__ __device__ __forceinline__ void stage_rc(int b, int& R, int& C) { const int st = b / 1024, sb = b % 1024, swz = sb ^ (((sb >> 9) & 1) << 5); R = (st >> 1) * 16 + swz / 64; C = (st & 1) * 32 + (swz % 64) / 2; }
__host__ __device__ __forceinline__ int perm32(int rho) { const int n = rho >> 4, i = rho & 15; return 8 * (i >> 2) + 4 * n + (i & 3); }

struct Unit { int pm, pn, e, kofs, nt; };
struct Gemm { const bf16_t* A; const bf16_t* Bt; int K; size_t bstride; const int* rows; unsigned* dep = nullptr; };

struct StaticOrder {
    int nM, nN, nwg, G, c, nt;
    __device__ void init(int M, int N, int K, int G_, int c_) { nM = M / BM; nN = N / BM; nwg = nM * nN; G = G_; c = c_; nt = K / BK; }
    __device__ bool next(int i, Unit& u) const {
        const long L = (long)i * G + c; if (L >= nwg) return false;
        int wgid = (int)L; { const int q = nwg / NXCD, r = nwg % NXCD, xcd = wgid % NXCD, off = wgid / NXCD; wgid = (xcd < r ? xcd * (q + 1) : r * (q + 1) + (xcd - r) * q) + off; }
        const int nig = WGM * nN, gid = wgid / nig, fm = gid * WGM, gsz = (nM - fm) < WGM ? (nM - fm) : WGM;
        u.pm = fm + ((wgid % nig) % gsz); u.pn = (wgid % nig) / gsz; u.e = 0; u.kofs = 0; u.nt = nt; return true;
    }
};
struct MoeOrder {
    const int* tb; int G, c, nt;
    __device__ bool next(int i, Unit& u) const {
        const int L = i * G + c; const int mt = L >> 3;
        if (mt >= tb[16]) return false;
        int e = 0;
#pragma unroll
        for (int k = 1; k < 16; ++k) e += (mt >= tb[k]) ? 1 : 0;
        u.pm = mt; u.pn = L & 7; u.e = e; u.kofs = 0; u.nt = nt; return true;
    }
};

struct DownOrder {
    const int* tb; int G, c, nt;
    __device__ bool next(int i, Unit& u) const {
        const int T = tb[16], NU = 8 * T, H = NU % G, nl = G - H;
        int d;
        if (H == 0) d = i * G + c;
        else if (c >= H) d = (i < 2) ? i * nl + (c - H) : 2 * nl + (i - 2) * G + c;
        else d = 2 * nl + i * G + c;
        if (d >= NU) return false;
        const int mt = d >> 3; int e = 0;
#pragma unroll
        for (int k = 1; k < 16; ++k) e += (mt >= tb[k]) ? 1 : 0;
        u.pm = mt; u.pn = d & 7; u.e = e; u.kofs = 0; u.nt = nt; return true;
    }
};
template <class Epi, class Sched, bool GATHER, int DEP = 0>
__device__ __forceinline__ void gemm_phase(FX_LAS unsigned char* lds, const int tid, const Gemm g, const Sched& S, const Epi& E) {
    const int wid = __builtin_amdgcn_readfirstlane(tid >> 6), lane = tid & 63, wr = wid >> 2, wc = wid & 3, fr = lane & 15, fq = lane >> 4;
    const int K = g.K;
    int Rr[2], Cc[2]; unsigned voffB[2];
#pragma unroll
    for (int i = 0; i < 2; ++i) { int R, C; stage_rc(tid * 16 + i * 8192, R, C); const int Rb = Epi::PERM ? ((R & ~31) + perm32(R & 31)) : R; Rr[i] = R; Cc[i] = C; voffB[i] = (unsigned)(Rb * K + C) * 2u; }
    const size_t kstep = (size_t)(BK * 2);
    const size_t hstep = (size_t)HALF * K * 2;
    const size_t tstep = 2 * hstep;
    const unsigned ldsw = (unsigned)wid * 1024u;
    const int aoff = lds_byte(wr * 64 + fr, fq * 8), boff = lds_byte(wc * 32 + fr, fq * 8);
#define PG8_SA(b, h) (((b) * 2 + (h)) * HTB)
#define PG8_SB(b, h) ((4 + (b) * 2 + (h)) * HTB)
#define PG8_STAGE(bufoff, gbase, voff) do { _Pragma("unroll") for (int _i = 0; _i < 2; ++_i) \
        __builtin_amdgcn_global_load_lds((const unsigned*)((const char*)(gbase) + (voff)[_i]), (FX_LAS unsigned*)(lds + (bufoff) + ldsw + _i * 8192), 16, 0, 0); } while (0)
#define PG8_LDA(dst, b, h) do { _Pragma("unroll") for (int m = 0; m < 4; ++m) _Pragma("unroll") for (int k = 0; k < 2; ++k) dst[m][k] = *(const FX_LAS bf16x8*)(lds + PG8_SA(b, h) + aoff + m * 2048 + k * 1024); } while (0)
#define PG8_LDB(dst, b, h) do { _Pragma("unroll") for (int n = 0; n < 2; ++n) _Pragma("unroll") for (int k = 0; k < 2; ++k) dst[n][k] = *(const FX_LAS bf16x8*)(lds + PG8_SB(b, h) + boff + n * 2048 + k * 1024); } while (0)
#define PG8_MMA(ai, bj, At, Bt) do { __builtin_amdgcn_s_setprio(1); _Pragma("unroll") for (int m = 0; m < 4; ++m) _Pragma("unroll") for (int n = 0; n < 2; ++n) _Pragma("unroll") for (int k = 0; k < 2; ++k) \
        acc[ai][bj][m][n] = __builtin_amdgcn_mfma_f32_16x16x32_bf16(Bt[n][k], At[m][k], acc[ai][bj][m][n], 0, 0, 0); __builtin_amdgcn_s_setprio(0); } while (0)
#define PG8_WAIT_V(n) asm volatile("s_waitcnt vmcnt(" #n ")" ::: "memory")
#define PG8_WAIT_L(n) asm volatile("s_waitcnt lgkmcnt(" #n ")" ::: "memory")
#define PG8_BAR __builtin_amdgcn_s_barrier()
#define PG8_SCHED __builtin_amdgcn_sched_barrier(0)
#define PG8_AOFFS(dst, u) do { _Pragma("unroll") for (int _h = 0; _h < 2; ++_h) _Pragma("unroll") for (int _i = 0; _i < 2; ++_i) { \
        const int _r = (u).pm * BM + _h * HALF + Rr[_i]; const int _s = GATHER ? g.rows[_r] : _r; dst[_h][_i] = (unsigned)(_s * K + Cc[_i]) * 2u; } } while (0)
#define PG8_DEPWAIT(tile) do { if (wid == 0) { const unsigned* _w = g.dep + (tile); unsigned _sp = 0; \
            while ((unsigned)__builtin_amdgcn_readfirstlane((int)__hip_atomic_load(_w, __ATOMIC_RELAXED, __HIP_MEMORY_SCOPE_AGENT)) < 8u && ++_sp < (1u << 22)) __builtin_amdgcn_s_sleep(1); \
            __builtin_amdgcn_fence(__ATOMIC_ACQUIRE, "agent"); asm volatile("s_waitcnt vmcnt(0)" ::: "memory"); } \
        PG8_BAR; } while (0)
    Unit cur, nxt; int ui = 0;
    if (!S.next(0, cur)) return;
    if (DEP == 2) PG8_DEPWAIT(cur.pm);
    f32x4 acc[2][2][4][2];
#pragma unroll
    for (int a = 0; a < 2; ++a)
#pragma unroll
        for (int b = 0; b < 2; ++b)
#pragma unroll
            for (int m = 0; m < 4; ++m)
#pragma unroll
                for (int n = 0; n < 2; ++n) acc[a][b][m][n] = (f32x4){0.f, 0.f, 0.f, 0.f};
    bf16x8 At[4][2], B0[2][2], B1[2][2];
    const char* Ab = (const char*)g.A + cur.kofs;
    unsigned oA[2][2], nOA[2][2];
    PG8_AOFFS(oA, cur);
    const char* cB = (const char*)g.Bt + (size_t)cur.e * g.bstride + (size_t)cur.pn * tstep + cur.kofs;
    PG8_STAGE(PG8_SB(0, 0), cB, voffB); PG8_STAGE(PG8_SB(0, 1), cB + hstep, voffB); PG8_STAGE(PG8_SA(0, 0), Ab, oA[0]); PG8_STAGE(PG8_SA(0, 1), Ab, oA[1]);
    if (wr == 1) PG8_BAR;
    PG8_WAIT_V(2); PG8_BAR;
    PG8_STAGE(PG8_SB(1, 0), cB + kstep, voffB); PG8_STAGE(PG8_SA(1, 0), Ab + kstep, oA[0]); PG8_STAGE(PG8_SB(1, 1), cB + hstep + kstep, voffB);
    PG8_WAIT_V(6); PG8_BAR;
    for (;;) {
        const bool has_next = S.next(ui + 1, nxt);
        if (has_next) { PG8_AOFFS(nOA, nxt); }
        else {
#pragma unroll
            for (int h = 0; h < 2; ++h)
#pragma unroll
                for (int i = 0; i < 2; ++i) nOA[h][i] = oA[h][i];
        }
        const char* nB = has_next ? (const char*)g.Bt + (size_t)nxt.e * g.bstride + (size_t)nxt.pn * tstep + nxt.kofs : cB;
        const char* nAb = has_next ? (const char*)g.A + nxt.kofs : Ab;
        const int nt = cur.nt;
        for (int t = 0; t < nt; t += 2) {
            const bool last = (t == nt - 2);
            if (DEP == 2) { if (last && has_next) PG8_DEPWAIT(nxt.pm); }
            const char* a1 = Ab + (size_t)(t + 1) * kstep;
            const char* a2 = last ? nAb : Ab + (size_t)(t + 2) * kstep; const char* b2 = last ? nB : cB + (size_t)(t + 2) * kstep;
            const char* a3 = a2 + kstep; const char* b3 = b2 + kstep;
            unsigned s0[2], s1[2];
#pragma unroll
            for (int i = 0; i < 2; ++i) { s0[i] = last ? nOA[0][i] : oA[0][i]; s1[i] = last ? nOA[1][i] : oA[1][i]; }
            PG8_LDB(B0, 0, 0); PG8_LDB(B1, 0, 1); PG8_SCHED; PG8_LDA(At, 0, 0); PG8_STAGE(PG8_SA(1, 1), a1, oA[1]);
            PG8_WAIT_V(8); PG8_WAIT_L(0); PG8_BAR; PG8_MMA(0, 0, At, B0); PG8_MMA(0, 1, At, B1); PG8_BAR; PG8_SCHED;
            PG8_LDA(At, 0, 1); PG8_STAGE(PG8_SB(0, 0), b2, voffB); PG8_STAGE(PG8_SB(0, 1), b2 + hstep, voffB); PG8_STAGE(PG8_SA(0, 0), a2, s0);
            PG8_WAIT_V(8); PG8_WAIT_L(0); PG8_BAR; PG8_MMA(1, 0, At, B0); PG8_MMA(1, 1, At, B1); PG8_BAR; PG8_SCHED;
            PG8_LDB(B0, 1, 0); PG8_LDB(B1, 1, 1); PG8_SCHED; PG8_LDA(At, 1, 0); PG8_STAGE(PG8_SA(0, 1), a2, s1);
            PG8_WAIT_V(8); PG8_WAIT_L(0); PG8_BAR; PG8_MMA(0, 0, At, B0); PG8_MMA(0, 1, At, B1); PG8_BAR; PG8_SCHED;
            PG8_LDA(At, 1, 1); PG8_STAGE(PG8_SB(1, 0), b3, voffB); PG8_STAGE(PG8_SB(1, 1), b3 + hstep, voffB); PG8_STAGE(PG8_SA(1, 0), a3, s0);
            PG8_WAIT_V(8); PG8_WAIT_L(0); PG8_BAR; PG8_MMA(1, 0, At, B0); PG8_MMA(1, 1, At, B1); PG8_BAR; PG8_SCHED;
        }
        if (wr == 0) PG8_BAR;
        bool keep = false;
        if constexpr (Epi::MIDSCALE) { if (cur.e < 2) { E.mid(acc, cur, cur.e, wr, wc, fr, fq); keep = true; } else E(acc, cur, wr, wc, fr, fq); }
        else E(acc, cur, wr, wc, fr, fq);
        if (DEP == 1) { PG8_WAIT_V(0); PG8_BAR; if (tid == 0) __hip_atomic_fetch_add(g.dep + cur.pm, 1u, __ATOMIC_RELAXED, __HIP_MEMORY_SCOPE_AGENT); }
        if (!has_next) break;
        if (!keep) {
#pragma unroll
        for (int a = 0; a < 2; ++a)
#pragma unroll
            for (int b = 0; b < 2; ++b)
#pragma unroll
                for (int m = 0; m < 4; ++m)
#pragma unroll
                    for (int n = 0; n < 2; ++n) acc[a][b][m][n] = (f32x4){0.f, 0.f, 0.f, 0.f};
        }
        cur = nxt; cB = nB; Ab = nAb; ++ui;
#pragma unroll
        for (int h = 0; h < 2; ++h)
#pragma unroll
            for (int i = 0; i < 2; ++i) oA[h][i] = nOA[h][i];
        if (wr == 1) PG8_BAR;
    }
    PG8_WAIT_V(0);
    PG8_BAR;
#undef PG8_SA
#undef PG8_SB
#undef PG8_STAGE
#undef PG8_LDA
#undef PG8_LDB
#undef PG8_MMA
#undef PG8_WAIT_V
#undef PG8_WAIT_L
#undef PG8_BAR
#undef PG8_SCHED
#undef PG8_AOFFS
#undef PG8_DEPWAIT
}

struct EpiInProj {
    static constexpr bool PERM = true; static constexpr bool MIDSCALE = false;
    bf16_t* act; float* small;
    __device__ __forceinline__ void operator()(const f32x4 (&acc)[2][2][4][2], const Unit& u, int wr, int wc, int fr, int fq) const {
        const int row0 = u.pm * BM + wr * 64 + fr;
        if (u.pn == 46) {
            if (wc == 0) {
#pragma unroll
                for (int ai = 0; ai < 2; ++ai)
#pragma unroll
                    for (int m = 0; m < 4; ++m) { float* p = small + (size_t)(row0 + ai * HALF + m * 16) * 32 + 8 * fq; *(f32x4*)p = acc[ai][0][m][0]; *(f32x4*)(p + 4) = acc[ai][0][m][1]; }
            }
            return;
        }
        const int mode = (u.pn < 2) ? 1 : (u.pn >= 22 ? 2 : 0);
        const int col0 = u.pn * BM + wc * 32 + 8 * fq;
#pragma unroll
        for (int ai = 0; ai < 2; ++ai)
#pragma unroll
            for (int m = 0; m < 4; ++m) { bf16_t* rowp = act + (size_t)(row0 + ai * HALF + m * 16) * NPAD + col0;
#pragma unroll
                for (int bj = 0; bj < 2; ++bj) { f32x4 v0 = acc[ai][bj][m][0], v1 = acc[ai][bj][m][1];
                    if (mode == 1) { v0 = v0 * CQK; v1 = v1 * CQK; }
                    if (mode == 2) {
#pragma unroll
                        for (int j = 0; j < 4; ++j) { v0[j] = sigmoid_f(v0[j]); v1[j] = sigmoid_f(v1[j]); } }
                    u32x4 w; w.x = cvt_pk_bf16(v0[0], v0[1]); w.y = cvt_pk_bf16(v0[2], v0[3]); w.z = cvt_pk_bf16(v1[0], v1[1]); w.w = cvt_pk_bf16(v1[2], v1[3]);
                    *(u32x4*)(rowp + bj * HALF) = w; } }
    }
};

struct Frame { FX_LAS unsigned char* lds; int tid, lane, wave, G, gw, NGW; };

__device__ __forceinline__ void transpose_item(const float* W, int ldw, int scol, int k0, bf16_t* WT, int Kd, int drow, FX_LAS float* scr, int lane) {
    f32x2 v[32];
#pragma unroll
    for (int i = 0; i < 32; ++i) { const int kk = 2 * i + (lane >> 5); v[i] = *(const f32x2*)(W + (size_t)(k0 + kk) * ldw + scol + 2 * (lane & 31)); }
#pragma unroll
    for (int i = 0; i < 32; ++i) { const int kk = 2 * i + (lane >> 5); scr[kk * 65 + 2 * (lane & 31)] = v[i][0]; scr[kk * 65 + 2 * (lane & 31) + 1] = v[i][1]; }
    asm volatile("s_waitcnt lgkmcnt(0)" ::: "memory");
    const int c = lane & 7;
#pragma unroll
    for (int j = 0; j < 8; ++j) { const int n = (lane >> 3) + 8 * j; const FX_LAS float* s = scr + (8 * c) * 65 + n;
        u32x4 o; o.x = cvt_pk_bf16(s[0 * 65], s[1 * 65]); o.y = cvt_pk_bf16(s[2 * 65], s[3 * 65]); o.z = cvt_pk_bf16(s[4 * 65], s[5 * 65]); o.w = cvt_pk_bf16(s[6 * 65], s[7 * 65]);
        *(u32x4*)(WT + (size_t)(drow + n) * Kd + k0 + 8 * c) = o; }
    asm volatile("s_waitcnt lgkmcnt(0)" ::: "memory");
}

constexpr int I_IN = 184 * 32, I_SB = 32 * 8, I_FOX = 32 * 8, I_SSM = 32 * 16, I_OUT = 32 * 32, I_G = 16 * 16 * 32, I_U = I_G, I_D = 16 * 32 * 16;
constexpr int I_LAYER = I_IN + I_SB + I_FOX + I_SSM + I_OUT + I_G + I_U + I_D;
__device__ __forceinline__ void convert_in1(const FX_CAS Args* a, const Frame& F) {
    FX_LAS float* scr = (FX_LAS float*)(F.lds + F.wave * 16896);
    for (int r0 = F.gw; r0 < I_IN; r0 += F.NGW) { const int r = I_IN - 1 - r0; const int nb = r / 32, kb = r % 32, dcol = nb * 64, scol = dcol + (dcol < 3072 ? 0 : (dcol < 5632 ? 4 : 20));
        transpose_item(a->in[5] + (size_t)D * NP, NP, scol, kb * 64, a->w_in_t + (size_t)NPAD * D, D, dcol, scr, F.lane); }
}
__device__ __forceinline__ void convert_brout(const FX_CAS Args* a, const Frame& F, int l, int wf, int nf) {
    FX_LAS float* scr = (FX_LAS float*)(F.lds + F.wave * 16896);
    bf16_t* br = a->w_br_t + (size_t)l * D * D;
    for (int r0 = wf; r0 < I_SB + I_FOX + I_SSM + I_OUT; r0 += nf) { int r = r0;
        if (r < I_SB) { const int nb = r / 8, kb = r % 8; transpose_item(a->in[15] + (size_t)l * 512 * D, D, nb * 64, kb * 64, br, D, nb * 64, scr, F.lane); continue; } r -= I_SB;
        if (r < I_FOX) { const int nb = r / 8, kb = r % 8; transpose_item(a->in[16] + (size_t)l * 512 * D, D, nb * 64, kb * 64, br + 512, D, nb * 64, scr, F.lane); continue; } r -= I_FOX;
        if (r < I_SSM) { const int nb = r / 16, kb = r % 16; transpose_item(a->in[17] + (size_t)l * 1024 * D, D, nb * 64, kb * 64, br + 1024, D, nb * 64, scr, F.lane); continue; } r -= I_SSM;
        { const int nb = r / 32, kb = r % 32; transpose_item(a->in[18] + (size_t)l * D * D, D, nb * 64, kb * 64, a->w_out_t + (size_t)l * D * D, D, nb * 64, scr, F.lane); }
    }
}
__device__ __forceinline__ void moe_item(const FX_CAS Args* a, int l, int m, FX_LAS float* scr, int lane) {
    int r = m;
    if (r < I_G + I_U) { const int up = r >= I_G; if (up) r -= I_G; const int e = r / 512, q = r % 512, nb = q / 32, kb = q % 32;
        const float* src = (up ? a->in[23] : a->in[22]) + ((size_t)l * NE + e) * D * FF;
        bf16_t* dst = a->w_gu_t + ((size_t)l * NE + e) * (size_t)D * D;
        transpose_item(src, FF, nb * 64, kb * 64, dst, D, 256 * (nb >> 1) + 64 * (nb & 1) + (up ? 128 : 0), scr, lane); return; }
    r -= I_G + I_U;
    { const int e = r / 512, q = r % 512, nb = q / 16, kb = q % 16;
        transpose_item(a->in[24] + ((size_t)l * NE + e) * FF * D, D, nb * 64, kb * 64, a->w_d_t + ((size_t)l * NE + e) * (size_t)D * FF, FF, nb * 64, scr, lane); }
}
struct TrItem { const float* W; bf16_t* WT; int ldw, scol, k0, Kd, drow; };
__device__ __forceinline__ TrItem moe_item_desc(const FX_CAS Args* a, int l, int m) {
    TrItem t; int r = m;
    if (r < I_G + I_U) { const int up = r >= I_G; if (up) r -= I_G; const int e = r / 512, q = r % 512, nb = q / 32, kb = q % 32;
        t.W = (up ? a->in[23] : a->in[22]) + ((size_t)l * NE + e) * D * FF; t.WT = a->w_gu_t + ((size_t)l * NE + e) * (size_t)D * D;
        t.ldw = FF; t.scol = nb * 64; t.k0 = kb * 64; t.Kd = D; t.drow = 256 * (nb >> 1) + 64 * (nb & 1) + (up ? 128 : 0); return t; }
    r -= I_G + I_U;
    { const int e = r / 512, q = r % 512, nb = q / 16, kb = q % 16;
        t.W = a->in[24] + ((size_t)l * NE + e) * FF * D; t.WT = a->w_d_t + ((size_t)l * NE + e) * (size_t)D * FF;
        t.ldw = D; t.scol = nb * 64; t.k0 = kb * 64; t.Kd = FF; t.drow = nb * 64; return t; }
}
__device__ __forceinline__ void tr_load(const TrItem& t, int lane, f32x2 (&v)[32]) {
#pragma unroll
    for (int i = 0; i < 32; ++i) { const int kk = 2 * i + (lane >> 5); v[i] = *(const f32x2*)(t.W + (size_t)(t.k0 + kk) * t.ldw + t.scol + 2 * (lane & 31)); }
}
__device__ __forceinline__ void tr_store(const TrItem& t, int lane, const f32x2 (&v)[32], FX_LAS float* scr) {
#pragma unroll
    for (int i = 0; i < 32; ++i) { const int kk = 2 * i + (lane >> 5); scr[kk * 65 + 2 * (lane & 31)] = v[i][0]; scr[kk * 65 + 2 * (lane & 31) + 1] = v[i][1]; }
    asm volatile("s_waitcnt lgkmcnt(0)" ::: "memory");
    const int c = lane & 7;
#pragma unroll
    for (int j = 0; j < 8; ++j) { const int n = (lane >> 3) + 8 * j; const FX_LAS float* s = scr + (8 * c) * 65 + n;
        u32x4 o; o.x = cvt_pk_bf16(s[0 * 65], s[1 * 65]); o.y = cvt_pk_bf16(s[2 * 65], s[3 * 65]); o.z = cvt_pk_bf16(s[4 * 65], s[5 * 65]); o.w = cvt_pk_bf16(s[6 * 65], s[7 * 65]);
        *(u32x4*)(t.WT + (size_t)(t.drow + n) * t.Kd + t.k0 + 8 * c) = o; }
    asm volatile("s_waitcnt lgkmcnt(0)" ::: "memory");
}
constexpr int MOE_NA = 2048, MOE_NB = 3072;
__device__ __forceinline__ void convert_moe(const FX_CAS Args* a, const Frame& F, int l, int first, int count, int wf, int nf) {
    FX_LAS float* scr = (FX_LAS float*)(F.lds + F.wave * 16896);
    if (wf >= count) return;
    f32x2 v0[32], v1[32];
    TrItem t0 = moe_item_desc(a, l, first + wf), t1 = t0;
    tr_load(t0, F.lane, v0);
    for (int m = wf; m < count; m += 2 * nf) {
        const bool h1 = m + nf < count;
        if (h1) { t1 = moe_item_desc(a, l, first + m + nf); tr_load(t1, F.lane, v1); }
        tr_store(t0, F.lane, v0, scr);
        const bool h0 = m + 2 * nf < count;
        if (h0) { t0 = moe_item_desc(a, l, first + m + 2 * nf); tr_load(t0, F.lane, v0); }
        if (h1) tr_store(t1, F.lane, v1, scr);
    }
}
__device__ __forceinline__ void phase_prologue(const FX_CAS Args* a, const Frame& F) {
    FX_LAS float* scr = (FX_LAS float*)(F.lds + F.wave * 16896);
    {
        FX_LAS float* sc = (FX_LAS float*)(F.lds + 131072);
        for (int i = F.tid; i < D; i += NTHR) sc[i] = silu_f(a->in[1][i]);
        __syncthreads();
        for (int it = F.gw; it < 2 * 384; it += F.NGW) {
            const int l = it / 384, j0 = (it % 384) * 32, rg = F.lane >> 3, cg = F.lane & 7;
            const float* w = a->in[2] + (size_t)l * D * 6 * D + (size_t)rg * 6 * D + j0 + 4 * cg;
            f32x4 acc = (f32x4){0.f, 0.f, 0.f, 0.f};
            for (int i = 0; i < 256; i += 16) {
                f32x4 wv[16];
#pragma unroll
                for (int k = 0; k < 16; ++k) wv[k] = *(const f32x4*)(w + (size_t)(i + k) * 8 * 6 * D);
#pragma unroll
                for (int k = 0; k < 16; ++k) acc += wv[k] * sc[rg + 8 * (i + k)];
            }
#pragma unroll
            for (int k = 0; k < 4; ++k) { float v = acc[k]; const int ln = fx_lane(); v += shfl_xorl(v, 8, ln); v += shfl_xorl(v, 16, ln); v += shfl_xorl(v, 32, ln); acc[k] = v; }
            if (rg == 0) { const f32x4 bv = *(const f32x4*)(a->in[3] + l * 6 * D + j0 + 4 * cg); *(f32x4*)(a->mod + l * 6 * D + j0 + 4 * cg) = acc + bv; }
        }
    }
    __syncthreads();
    constexpr int I_BO = I_SB + I_FOX + I_SSM + I_OUT, I_MOE = I_G + I_U + I_D;
    const int nab = (gridDim.x == 256) ? MOE_NA + MOE_NB : 0;
    const int mrem = I_MOE - nab, ipro = I_IN + 2 * mrem;
    for (int j0 = F.gw; j0 < ipro; j0 += F.NGW) {
        const int j = ipro - 1 - j0;
        if (j < I_IN) { const int r = j; const int nb = r / 32, kb = r % 32, dcol = nb * 64, scol = dcol + (dcol < 3072 ? 0 : (dcol < 5632 ? 4 : 20));
            transpose_item(a->in[5], NP, scol, kb * 64, a->w_in_t, D, dcol, scr, F.lane); continue; }
        const int jj = j - I_IN; const int l = jj / mrem;
        moe_item(a, l, nab + jj % mrem, scr, F.lane);
    }
    for (int idx = F.gw * 64 + F.lane; idx < 2 * 256 * 256; idx += F.NGW * 64) {
        const int l = idx >> 16, rr = (idx >> 8) & 255, ch = idx & 255;
        u32x4 o = (u32x4){0u, 0u, 0u, 0u};
        if (rr < 20) { const int scol = rr < 4 ? 3072 + rr : 5636 + (rr - 4); const float* w = a->in[5] + (size_t)l * D * NP + (size_t)(ch * 8) * NP + scol;
            o.x = cvt_pk_bf16(w[0], w[NP]); o.y = cvt_pk_bf16(w[2 * (size_t)NP], w[3 * (size_t)NP]); o.z = cvt_pk_bf16(w[4 * (size_t)NP], w[5 * (size_t)NP]); o.w = cvt_pk_bf16(w[6 * (size_t)NP], w[7 * (size_t)NP]); }
        *(u32x4*)(a->w_in_t + (size_t)l * NPAD * D + (size_t)(C_SMALL + rr) * D + ch * 8) = o;
    }
}

template <bool COMBINE, bool NORM, bool XIN_BF = false, bool XOUT_BF = false>
__device__ __forceinline__ void phase_normmod(const Frame& F, const void* xin, void* xout, const float* gprev, const bf16_t* ybuf, const int* slot, const float* wsel, const bf16_t* delta,
                                               const float* gain, const float* scale, const float* shift, bf16_t* hb) {
    for (int m = F.gw; m < S; m += F.NGW) {
        f32x4 v[8];
        if (XIN_BF) { const u32x2* xr = (const u32x2*)((const bf16_t*)xin + (size_t)m * D) + F.lane;
#pragma unroll
            for (int j = 0; j < 8; ++j) { const u32x2 xv = xr[64 * j]; v[j] = (f32x4){bflo(xv.x), bfhi(xv.x), bflo(xv.y), bfhi(xv.y)}; } }
        else { const f32x4* xr = (const f32x4*)((const float*)xin + (size_t)m * D) + F.lane;
#pragma unroll
            for (int j = 0; j < 8; ++j) v[j] = xr[64 * j]; }
        if (COMBINE) {
            const int s0 = slot[m * 2], s1 = slot[m * 2 + 1]; const float w0 = wsel[m * 2], w1 = wsel[m * 2 + 1];
            const u32x2* y0 = (const u32x2*)(ybuf + (size_t)s0 * D) + F.lane; const u32x2* y1 = (const u32x2*)(ybuf + (size_t)s1 * D) + F.lane;
            const u32x2* dl = (const u32x2*)(delta + (size_t)m * D) + F.lane;
#pragma unroll
            for (int j = 0; j < 8; ++j) { const u32x2 dv = dl[64 * j]; v[j][0] += bflo(dv.x); v[j][1] += bfhi(dv.x); v[j][2] += bflo(dv.y); v[j][3] += bfhi(dv.y); }
#pragma unroll
            for (int j = 0; j < 8; ++j) { const u32x2 a0 = y0[64 * j], a1 = y1[64 * j]; const f32x4 gp = ((const f32x4*)gprev)[F.lane + 64 * j];
                v[j][0] += gp[0] * (w0 * bflo(a0.x) + w1 * bflo(a1.x)); v[j][1] += gp[1] * (w0 * bfhi(a0.x) + w1 * bfhi(a1.x));
                v[j][2] += gp[2] * (w0 * bflo(a0.y) + w1 * bflo(a1.y)); v[j][3] += gp[3] * (w0 * bfhi(a0.y) + w1 * bfhi(a1.y)); }
            if (XOUT_BF) { u32x2* xo = (u32x2*)((bf16_t*)xout + (size_t)m * D) + F.lane;
#pragma unroll
                for (int j = 0; j < 8; ++j) { u32x2 w; w.x = cvt_pk_bf16(v[j][0], v[j][1]); w.y = cvt_pk_bf16(v[j][2], v[j][3]); xo[64 * j] = w;
                    v[j] = (f32x4){bflo(w.x), bfhi(w.x), bflo(w.y), bfhi(w.y)}; } }
            else { f32x4* xo = (f32x4*)((float*)xout + (size_t)m * D) + F.lane;
#pragma unroll
                for (int j = 0; j < 8; ++j) xo[64 * j] = v[j]; }
        }
        if (NORM) {
            float ss = 0.f;
#pragma unroll
            for (int j = 0; j < 8; ++j) ss += (v[j][0] * v[j][0] + v[j][1] * v[j][1]) + (v[j][2] * v[j][2] + v[j][3] * v[j][3]);
            const float rs = rsqrtf(wave_sum(ss) * (1.0f / D) + 1e-6f);
            u32x2* o = (u32x2*)(hb + (size_t)m * D) + F.lane;
#pragma unroll
            for (int j = 0; j < 8; ++j) { const f32x4 gg = ((const f32x4*)gain)[F.lane + 64 * j], sc = ((const f32x4*)scale)[F.lane + 64 * j], sh = ((const f32x4*)shift)[F.lane + 64 * j];
                f32x4 h;
#pragma unroll
                for (int k = 0; k < 4; ++k) h[k] = v[j][k] * rs * gg[k] * (1.0f + sc[k]) + sh[k];
                u32x2 w; w.x = cvt_pk_bf16(h[0], h[1]); w.y = cvt_pk_bf16(h[2], h[3]); o[64 * j] = w; }
        }
    }
}

template <bool FIRST> struct EpiBranch {
    static constexpr bool PERM = true; static constexpr bool MIDSCALE = false;
    const bf16_t* gates; bf16_t* merged;
    __device__ __forceinline__ void operator()(const f32x4 (&acc)[2][2][4][2], const Unit& u, int wr, int wc, int fr, int fq) const {
        const int row0 = u.pm * BM + wr * 64 + fr, col0 = u.pn * BM + wc * 32 + 8 * fq;
#pragma unroll
        for (int ai = 0; ai < 2; ++ai)
#pragma unroll
            for (int m = 0; m < 4; ++m) { const size_t row = (size_t)(row0 + ai * HALF + m * 16);
#pragma unroll
                for (int bj = 0; bj < 2; ++bj) { const int col = col0 + bj * HALF;
                    const u32x4 gw = *(const u32x4*)(gates + row * NPAD + col);
                    u32x4 pw = (u32x4){0u, 0u, 0u, 0u}; if (!FIRST) pw = *(const u32x4*)(merged + row * D + col);
                    const f32x4 v0 = acc[ai][bj][m][0], v1 = acc[ai][bj][m][1];
                    float o[8];
                    o[0] = bflo(pw.x) + bflo(gw.x) * v0[0]; o[1] = bfhi(pw.x) + bfhi(gw.x) * v0[1]; o[2] = bflo(pw.y) + bflo(gw.y) * v0[2]; o[3] = bfhi(pw.y) + bfhi(gw.y) * v0[3];
                    o[4] = bflo(pw.z) + bflo(gw.z) * v1[0]; o[5] = bfhi(pw.z) + bfhi(gw.z) * v1[1]; o[6] = bflo(pw.w) + bflo(gw.w) * v1[2]; o[7] = bfhi(pw.w) + bfhi(gw.w) * v1[3];
                    u32x4 w; w.x = cvt_pk_bf16(o[0], o[1]); w.y = cvt_pk_bf16(o[2], o[3]); w.z = cvt_pk_bf16(o[4], o[5]); w.w = cvt_pk_bf16(o[6], o[7]);
                    *(u32x4*)(merged + row * D + col) = w; } }
    }
};
struct EpiOut {
    static constexpr bool PERM = true; static constexpr bool MIDSCALE = false;
    bf16_t* delta; const float* gm;
    __device__ __forceinline__ void operator()(const f32x4 (&acc)[2][2][4][2], const Unit& u, int wr, int wc, int fr, int fq) const {
        const int row0 = u.pm * BM + wr * 64 + fr, col0 = u.pn * BM + wc * 32 + 8 * fq;
        f32x4 gv[2][2];
#pragma unroll
        for (int bj = 0; bj < 2; ++bj)
#pragma unroll
            for (int n = 0; n < 2; ++n) gv[bj][n] = *(const f32x4*)(gm + col0 + bj * HALF + n * 4);
#pragma unroll
        for (int ai = 0; ai < 2; ++ai)
#pragma unroll
            for (int m = 0; m < 4; ++m) { bf16_t* rowp = delta + (size_t)(row0 + ai * HALF + m * 16) * D + col0;
#pragma unroll
                for (int bj = 0; bj < 2; ++bj) { const f32x4 v0 = acc[ai][bj][m][0] * gv[bj][0], v1 = acc[ai][bj][m][1] * gv[bj][1];
                    u32x4 w; w.x = cvt_pk_bf16(v0[0], v0[1]); w.y = cvt_pk_bf16(v0[2], v0[3]); w.z = cvt_pk_bf16(v1[0], v1[1]); w.w = cvt_pk_bf16(v1[2], v1[3]);
                    *(u32x4*)(rowp + bj * HALF) = w; } }
    }
};
struct EpiGateUp {
    static constexpr bool PERM = true; static constexpr bool MIDSCALE = false;
    bf16_t* actb;
    __device__ __forceinline__ void operator()(const f32x4 (&acc)[2][2][4][2], const Unit& u, int wr, int wc, int fr, int fq) const {
        const int row0 = u.pm * BM + wr * 64 + fr, col0 = u.pn * HALF + wc * 32 + 8 * fq;
        const __amdgpu_buffer_rsrc_t rsrc = __builtin_amdgcn_make_buffer_rsrc(actb, 0, SLOTCAP * FF * 2, 0x00020000);
#pragma unroll
        for (int ai = 0; ai < 2; ++ai)
#pragma unroll
            for (int m = 0; m < 4; ++m) { const size_t row = (size_t)(row0 + ai * HALF + m * 16);
                float o[8];
#pragma unroll
                for (int n = 0; n < 2; ++n)
#pragma unroll
                    for (int j = 0; j < 4; ++j) o[n * 4 + j] = silu_f(acc[ai][0][m][n][j]) * acc[ai][1][m][n][j];
                u32x4 w; w.x = cvt_pk_bf16(o[0], o[1]); w.y = cvt_pk_bf16(o[2], o[3]); w.z = cvt_pk_bf16(o[4], o[5]); w.w = cvt_pk_bf16(o[6], o[7]);
                __builtin_amdgcn_raw_buffer_store_b128(w, rsrc, (unsigned)((row * FF + col0) * 2), 0, 16); }
    }
};
struct EpiDown {
    static constexpr bool PERM = true; static constexpr bool MIDSCALE = false;
    bf16_t* ybuf;
    __device__ __forceinline__ void operator()(const f32x4 (&acc)[2][2][4][2], const Unit& u, int wr, int wc, int fr, int fq) const {
        const int row0 = u.pm * BM + wr * 64 + fr, col0 = u.pn * BM + wc * 32 + 8 * fq;
#pragma unroll
        for (int ai = 0; ai < 2; ++ai)
#pragma unroll
            for (int m = 0; m < 4; ++m) { bf16_t* rowp = ybuf + (size_t)(row0 + ai * HALF + m * 16) * D + col0;
#pragma unroll
                for (int bj = 0; bj < 2; ++bj) { const f32x4 v0 = acc[ai][bj][m][0], v1 = acc[ai][bj][m][1];
                    u32x4 w; w.x = cvt_pk_bf16(v0[0], v0[1]); w.y = cvt_pk_bf16(v0[2], v0[3]); w.z = cvt_pk_bf16(v1[0], v1[1]); w.w = cvt_pk_bf16(v1[2], v1[3]);
                    *(u32x4*)(rowp + bj * HALF) = w; } }
    }
};

struct EpiBranchRT {
    static constexpr bool PERM = true; static constexpr bool MIDSCALE = false;
    const bf16_t* gates; bf16_t* merged;
    __device__ __forceinline__ void operator()(const f32x4 (&acc)[2][2][4][2], const Unit& u, int wr, int wc, int fr, int fq) const {
        const int row0 = u.pm * BM + wr * 64 + fr, col0 = u.pn * BM + wc * 32 + 8 * fq;
        const bool first = (u.e == 0);
        const bf16_t* gb = gates + (size_t)u.e * D;
#pragma unroll
        for (int ai = 0; ai < 2; ++ai)
#pragma unroll
            for (int m = 0; m < 4; ++m) { const size_t row = (size_t)(row0 + ai * HALF + m * 16);
#pragma unroll
                for (int bj = 0; bj < 2; ++bj) { const int col = col0 + bj * HALF;
                    const u32x4 gw = *(const u32x4*)(gb + row * NPAD + col);
                    u32x4 pw = (u32x4){0u, 0u, 0u, 0u}; if (!first) pw = *(const u32x4*)(merged + row * D + col);
                    const f32x4 v0 = acc[ai][bj][m][0], v1 = acc[ai][bj][m][1];
                    float o[8];
                    o[0] = bflo(pw.x) + bflo(gw.x) * v0[0]; o[1] = bfhi(pw.x) + bfhi(gw.x) * v0[1]; o[2] = bflo(pw.y) + bflo(gw.y) * v0[2]; o[3] = bfhi(pw.y) + bfhi(gw.y) * v0[3];
                    o[4] = bflo(pw.z) + bflo(gw.z) * v1[0]; o[5] = bfhi(pw.z) + bfhi(gw.z) * v1[1]; o[6] = bflo(pw.w) + bflo(gw.w) * v1[2]; o[7] = bfhi(pw.w) + bfhi(gw.w) * v1[3];
                    u32x4 w; w.x = cvt_pk_bf16(o[0], o[1]); w.y = cvt_pk_bf16(o[2], o[3]); w.z = cvt_pk_bf16(o[4], o[5]); w.w = cvt_pk_bf16(o[6], o[7]);
                    *(u32x4*)(merged + row * D + col) = w; } }
    }
};
struct EpiBranchFused {
    static constexpr bool PERM = true; static constexpr bool MIDSCALE = true;
    const bf16_t* gates; bf16_t* merged;
    __device__ __forceinline__ void mid(f32x4 (&acc)[2][2][4][2], const Unit& u, int e, int wr, int wc, int fr, int fq) const {
        const char* ga = (const char*)(gates + (size_t)e * D);
        const unsigned off0 = (unsigned)((u.pm * BM + wr * 64 + fr) * NPAD + u.pn * BM + wc * 32 + 8 * fq) * 2u;
#pragma unroll
        for (int ai = 0; ai < 2; ++ai) {
#pragma unroll
            for (int m = 0; m < 4; ++m) {
#pragma unroll
                for (int bj = 0; bj < 2; ++bj) { const unsigned off = off0 + (unsigned)(((ai * HALF + m * 16) * NPAD + bj * HALF) * 2);
                    const u32x4 pa = *(const u32x4*)(ga + off), pb = *(const u32x4*)(ga + D * 2 + off);
                    float r[8];
                    r[0] = bflo(pa.x) * fast_rcp(fmaxf(bflo(pb.x), 1e-20f)); r[1] = bfhi(pa.x) * fast_rcp(fmaxf(bfhi(pb.x), 1e-20f));
                    r[2] = bflo(pa.y) * fast_rcp(fmaxf(bflo(pb.y), 1e-20f)); r[3] = bfhi(pa.y) * fast_rcp(fmaxf(bfhi(pb.y), 1e-20f));
                    r[4] = bflo(pa.z) * fast_rcp(fmaxf(bflo(pb.z), 1e-20f)); r[5] = bfhi(pa.z) * fast_rcp(fmaxf(bfhi(pb.z), 1e-20f));
                    r[6] = bflo(pa.w) * fast_rcp(fmaxf(bflo(pb.w), 1e-20f)); r[7] = bfhi(pa.w) * fast_rcp(fmaxf(bfhi(pb.w), 1e-20f));
#pragma unroll
                    for (int j = 0; j < 4; ++j) { acc[ai][bj][m][0][j] *= r[j]; acc[ai][bj][m][1][j] *= r[4 + j]; } } }
            __builtin_amdgcn_sched_barrier(0);
        }
    }
    __device__ __forceinline__ void operator()(const f32x4 (&acc)[2][2][4][2], const Unit& u, int wr, int wc, int fr, int fq) const {
        const int row0 = u.pm * BM + wr * 64 + fr, col0 = u.pn * BM + wc * 32 + 8 * fq;
        const bf16_t* gb = gates + (size_t)2 * D;
#pragma unroll
        for (int ai = 0; ai < 2; ++ai)
#pragma unroll
            for (int m = 0; m < 4; ++m) { const size_t row = (size_t)(row0 + ai * HALF + m * 16);
#pragma unroll
                for (int bj = 0; bj < 2; ++bj) { const int col = col0 + bj * HALF;
                    const u32x4 gw = *(const u32x4*)(gb + row * NPAD + col);
                    const f32x4 v0 = acc[ai][bj][m][0], v1 = acc[ai][bj][m][1];
                    u32x4 w; w.x = cvt_pk_bf16(bflo(gw.x) * v0[0], bfhi(gw.x) * v0[1]); w.y = cvt_pk_bf16(bflo(gw.y) * v0[2], bfhi(gw.y) * v0[3]);
                    w.z = cvt_pk_bf16(bflo(gw.z) * v1[0], bfhi(gw.z) * v1[1]); w.w = cvt_pk_bf16(bflo(gw.w) * v1[2], bfhi(gw.w) * v1[3]);
                    *(u32x4*)(merged + row * D + col) = w; } }
    }
};
struct BranchOrder {
    StaticOrder so;
    __device__ bool next(int i, Unit& u) const {
        if (i >= 3) return false;
        if (!so.next(0, u)) return false;
        u.e = i; u.kofs = (i == 0) ? 0 : ((i == 1) ? 1024 : 2048); u.nt = (i == 2) ? 16 : 8; return true;
    }
};
__device__ __forceinline__ void phase_branch(const FX_CAS Args* a, const Frame& F, int l) {
    Gemm g{a->osb, a->w_br_t + (size_t)l * D * D, D, 0, nullptr};
    BranchOrder Bo; Bo.so.init(S, D, D, F.G, (int)blockIdx.x);
    EpiBranchFused E{a->act + C_GATE, a->merged};
    gemm_phase<EpiBranchFused, BranchOrder, false>(F.lds, F.tid, g, Bo, E);
}
__device__ __forceinline__ void phase_out(const FX_CAS Args* a, const Frame& F, int l) {
    Gemm g{a->merged, a->w_out_t + (size_t)l * D * D, D, 0, nullptr}; StaticOrder So; So.init(S, D, D, F.G, (int)blockIdx.x);
    EpiOut E{a->osb, a->mod + (size_t)l * 6 * D + 2 * D};
    gemm_phase<EpiOut, StaticOrder, false>(F.lds, F.tid, g, So, E);
}

__device__ __forceinline__ unsigned offV(unsigned row, unsigned ch) { return 256u * row + 16u * (ch ^ (((row & 3u) << 2) | ((row >> 2) & 3u))); }
__device__ __forceinline__ unsigned offK(unsigned row, unsigned ch) { return 256u * row + 16u * (ch ^ ((((row >> 3) & 3u) << 2) | (row & 3u))); }
__device__ __forceinline__ unsigned trV16(unsigned lane, unsigned c, unsigned ks, unsigned t) {
    const unsigned g = lane >> 4, q = (lane & 15u) >> 2, p = lane & 3u;
    return offV(32u * ks + 8u * g + 4u * t + q, 2u * c + (p >> 1)) + 8u * (p & 1u);
}
__device__ __forceinline__ unsigned offVa(unsigned row, unsigned ch) { return 2048u * (row >> 3) + 512u * (ch >> 2) + 64u * (row & 7u) + 16u * ((ch & 3u) ^ ((row >> 2) & 3u)); }
__device__ __forceinline__ unsigned trVa16(unsigned lane, unsigned c, unsigned ks, unsigned t) {
    const unsigned g = lane >> 4, q = (lane & 15u) >> 2, p = lane & 3u;
    return offVa(32u * ks + 8u * g + 4u * t + q, 2u * c + (p >> 1)) + 8u * (p & 1u);
}
#define ATT_BAR() do { __builtin_amdgcn_sched_barrier(0); asm volatile("s_waitcnt lgkmcnt(0)" ::: "memory"); __syncthreads(); __builtin_amdgcn_sched_barrier(0); } while (0)
#ifndef ATT_NOSTAG
#define ATT_NOSTAG 0
#endif
constexpr int ATT_KS = 0, ATT_VS = 32768, ATT_FTAB = 65536;

template <int KOFF>
__device__ __forceinline__ void att_qk(FX_LAS unsigned char* lds, const unsigned (&kbase)[4], const bf16x8 (&qf)[4], f32x4 (&st)[2][2]) {
    bf16x8 kf[2][2][4];
#pragma unroll
    for (int ks = 0; ks < 2; ++ks)
#pragma unroll
        for (int t = 0; t < 2; ++t)
#pragma unroll
            for (int kk = 0; kk < 4; ++kk) kf[ks][t][kk] = *(const FX_LAS bf16x8*)(lds + kbase[kk] + (KOFF + 8192 * ks + 1024 * t));
#pragma unroll
    for (int ks = 0; ks < 2; ++ks)
#pragma unroll
        for (int t = 0; t < 2; ++t) { f32x4 acc = (f32x4){0.f, 0.f, 0.f, 0.f};
#pragma unroll
            for (int kk = 0; kk < 4; ++kk) acc = __builtin_amdgcn_mfma_f32_16x16x32_bf16(kf[ks][t][kk], qf[kk], acc, 0, 0, 0);
            st[ks][t] = acc; }
}
template <int VOFF>
__device__ __forceinline__ void att_pv(FX_LAS unsigned char* lds, const unsigned (&vbase)[8][2], const bf16x8 (&pf)[2], f32x4 (&ot)[8]) {
#pragma unroll
    for (int hc = 0; hc < 2; ++hc) {
        s16x4 vr[4][2][2];
#pragma unroll
        for (int c = 0; c < 4; ++c)
#pragma unroll
            for (int ks = 0; ks < 2; ++ks)
#pragma unroll
                for (int t = 0; t < 2; ++t) vr[c][ks][t] = __builtin_amdgcn_ds_read_tr16_b64_v4i16((FX_LAS s16x4*)(lds + vbase[4 * hc + c][t] + (VOFF + 8192 * ks)));
#pragma unroll
        for (int c = 0; c < 4; ++c)
#pragma unroll
            for (int ks = 0; ks < 2; ++ks) { const bf16x8 vf = __builtin_shufflevector(vr[c][ks][0], vr[c][ks][1], 0, 1, 2, 3, 4, 5, 6, 7);
                ot[4 * hc + c] = __builtin_amdgcn_mfma_f32_16x16x32_bf16(vf, pf[ks], ot[4 * hc + c], 0, 0, 0); }
    }
}
template <bool FOX, bool MASK>
__device__ __forceinline__ void att_weights(const f32x4 (&st)[2][2], int j, int qrow, int g, int q, const FX_LAS float* ftab, float a_t, float& carry, float& den, bf16x8 (&pf)[2]) {
    const int keyb = 64 * j + 8 * g;
    float wgt[2][8];
    if (FOX) {
#pragma unroll
        for (int ks = 0; ks < 2; ++ks) {
            const f32x4 b0 = *(const FX_LAS f32x4*)(ftab + keyb + 32 * ks), b1 = *(const FX_LAS f32x4*)(ftab + keyb + 32 * ks + 4);
#pragma unroll
            for (int jj = 0; jj < 8; ++jj) { const float z = st[ks][jj >> 2][jj & 3], b = (jj < 4) ? b0[jj & 3] : b1[jj & 3];
                float p = fast_exp2(z + (a_t - b));
                if (MASK) p = ((keyb + 32 * ks + jj) <= qrow) ? p : 0.f;
                den += p; wgt[ks][jj] = p; }
        }
    } else {
        float tot1 = 1.0f;
#pragma unroll
        for (int ksi = 0; ksi < 2; ++ksi) { const int ks = 1 - ksi;
            float u[8], sfx[8];
#pragma unroll
            for (int jj = 0; jj < 8; ++jj) { const float z = __builtin_amdgcn_fmed3f(st[ks][jj >> 2][jj & 3], -1e30f, 60.f);
                float uu = fast_exp2(z), rr = fast_rcp(1.0f + uu);
                if (MASK) { const bool ok = (keyb + 32 * ks + jj) < qrow; uu = ok ? uu : 0.f; rr = ok ? rr : 1.f; }
                u[jj] = uu; sfx[jj] = rr; }
#pragma unroll
            for (int jj = 6; jj >= 0; --jj) sfx[jj] *= sfx[jj + 1];
            const float gp = sfx[0];
            const float g0 = shfl_idx(gp, q), g1 = shfl_idx(gp, 16 + q), g2 = shfl_idx(gp, 32 + q), g3 = shfl_idx(gp, 48 + q);
            const float t23 = g2 * g3;
            const float facq = (g == 0) ? g1 * t23 : ((g == 1) ? t23 : ((g == 2) ? g3 : 1.0f));
            const float tot = (g0 * g1) * t23;
            const float f = facq * tot1 * carry;
            if (ks == 1) tot1 = tot; else carry *= tot * tot1;
            u32x4 pw; pw.x = cvt_pk_bf16(u[0] * sfx[0] * f, u[1] * sfx[1] * f); pw.y = cvt_pk_bf16(u[2] * sfx[2] * f, u[3] * sfx[3] * f);
            pw.z = cvt_pk_bf16(u[4] * sfx[4] * f, u[5] * sfx[5] * f); pw.w = cvt_pk_bf16(u[6] * sfx[6] * f, u[7] * sfx[7] * f);
            pf[ks] = __builtin_bit_cast(bf16x8, pw);
            __builtin_amdgcn_sched_barrier(0);
        }
        return;
    }
#pragma unroll
    for (int ks = 0; ks < 2; ++ks) { u32x4 pw; pw.x = cvt_pk_bf16(wgt[ks][0], wgt[ks][1]); pw.y = cvt_pk_bf16(wgt[ks][2], wgt[ks][3]); pw.z = cvt_pk_bf16(wgt[ks][4], wgt[ks][5]); pw.w = cvt_pk_bf16(wgt[ks][6], wgt[ks][7]);
        pf[ks] = __builtin_bit_cast(bf16x8, pw); }
}

template <bool FOX>
__device__ __forceinline__ void attn_item(const Frame& F, const bf16_t* act, int qcol, int kcol, int vcol, int h, int qb, bf16_t* outp) {
    int lane_ = F.lane; asm volatile("" : "+v"(lane_));
    const int lane = lane_, w = F.wave, q = lane & 15, g = lane >> 4;
    const int qrow = qb * 128 + 16 * w + q;
    FX_LAS unsigned char* lds = F.lds;
    const FX_LAS float* ftab = (const FX_LAS float*)(lds + ATT_FTAB);
    bf16x8 qf[4];
#pragma unroll
    for (int kk = 0; kk < 4; ++kk) qf[kk] = *(const bf16x8*)((const char*)(act + qcol + h * 128) + (unsigned)(qrow * (NPAD * 2) + 64 * kk + 16 * g));
    f32x4 ot[8];
#pragma unroll
    for (int c = 0; c < 8; ++c) ot[c] = (f32x4){0.f, 0.f, 0.f, 0.f};
    float carry = 1.f, den = 0.f;
    const float a_t = FOX ? ftab[qrow] : 0.f;
    const int jmax = 2 * qb + 1, N = jmax + 1;
    const int sr = F.tid >> 4, sc = F.tid & 15;
    const char* kg = (const char*)(act + kcol + h * 128);
    const char* vg = (const char*)(act + vcol + h * 128);
    const unsigned lofs = (unsigned)((sr * NPAD + sc * 8) * 2);
    const unsigned wk0 = offK(sr, sc), wk1 = offK(sr + 32, sc), wv0 = offV(sr, sc), wv1 = offV(sr + 32, sc);
    unsigned kbase[4], vbase[8][2];
#pragma unroll
    for (int kk = 0; kk < 4; ++kk) kbase[kk] = 256u * (unsigned)(8 * (q >> 2) + (q & 3)) + 16u * ((unsigned)(4 * kk + g) ^ (unsigned)q);
#pragma unroll
    for (int c = 0; c < 8; ++c)
#pragma unroll
        for (int t = 0; t < 2; ++t) vbase[c][t] = trV16((unsigned)lane, (unsigned)c, 0u, (unsigned)t);
#define ATT_LOAD(base, n_, r0, r1) do { const char* _b = (base) + (size_t)(unsigned)__builtin_amdgcn_readfirstlane((jmax - (n_)) * (64 * NPAD * 2)); r0 = *(const u32x4*)(_b + lofs); r1 = *(const u32x4*)(_b + (size_t)(32 * NPAD * 2) + lofs); } while (0)
#define ATT_STK(slot, r0, r1) do { *(FX_LAS u32x4*)(lds + ATT_KS + (slot) * 16384u + wk0) = r0; *(FX_LAS u32x4*)(lds + ATT_KS + (slot) * 16384u + wk1) = r1; } while (0)
#define ATT_STV(slot, r0, r1) do { *(FX_LAS u32x4*)(lds + ATT_VS + (slot) * 16384u + wv0) = r0; *(FX_LAS u32x4*)(lds + ATT_VS + (slot) * 16384u + wv1) = r1; } while (0)
#define ATT_WEIGHTS(tile) do { const int _t = (tile); if (_t < 2) att_weights<FOX, true>(stc, jmax - _t, qrow, g, q, ftab, a_t, carry, den, pf); \
                                                 else        att_weights<FOX, false>(stc, jmax - _t, qrow, g, q, ftab, a_t, carry, den, pf); } while (0)
    u32x4 kr0, kr1, vr0, vr1;
    const bool roleA = ATT_NOSTAG || (w < 4);
#define ATT_ITER(n, SL, DOPV, MASKED) do { \
        if (roleA) { ATT_LOAD(kg, ((n) + 1 < N ? (n) + 1 : N - 1), kr0, kr1); ATT_LOAD(vg, (n), vr0, vr1); } \
        att_qk<ATT_KS + (SL) * 16384>(lds, kbase, qf, stc); \
        if (DOPV) att_pv<ATT_VS + (1 - (SL)) * 16384>(lds, vbase, pf, ot); \
        if (!roleA) { ATT_STK((unsigned)(1 - (SL)), kr0, kr1); ATT_STV((unsigned)(SL), vr0, vr1); } \
        ATT_BAR(); \
        if (!roleA) { ATT_LOAD(kg, ((n) + 2 < N ? (n) + 2 : N - 1), kr0, kr1); ATT_LOAD(vg, ((n) + 1 < N ? (n) + 1 : N - 1), vr0, vr1); } \
        att_weights<FOX, MASKED>(stc, jmax - (n), qrow, g, q, ftab, a_t, carry, den, pf); \
        if (roleA) { ATT_STK((unsigned)(1 - (SL)), kr0, kr1); ATT_STV((unsigned)(SL), vr0, vr1); } \
        ATT_BAR(); } while (0)
    ATT_BAR();
    ATT_LOAD(kg, 0, kr0, kr1); ATT_STK(0u, kr0, kr1);
    ATT_BAR();
    if (!roleA) { ATT_LOAD(kg, 1, kr0, kr1); ATT_LOAD(vg, 0, vr0, vr1); ATT_BAR(); }
    f32x4 stc[2][2]; bf16x8 pf[2];
    ATT_ITER(0, 0, false, true);
    ATT_ITER(1, 1, true, true);
    for (int n = 2; n < N; n += 2) { ATT_ITER(n, 0, true, false); ATT_ITER(n + 1, 1, true, false); }
    if (roleA && !ATT_NOSTAG) ATT_BAR();
    att_pv<ATT_VS + 16384>(lds, vbase, pf, ot);
#undef ATT_ITER
#undef ATT_LOAD
#undef ATT_STK
#undef ATT_STV
#undef ATT_WEIGHTS
    float inv = 1.0f;
    if (FOX) { den += shfl_xorl(den, 16, lane); den += shfl_xorl(den, 32, lane); inv = 1.0f / den; }
    char* op = (char*)(outp + h * 128); const unsigned oofs = (unsigned)((qrow * 2048 + 4 * g) * 2);
#pragma unroll
    for (int c = 0; c < 8; ++c) { u32x2 o; o.x = cvt_pk_bf16(ot[c][0] * inv, ot[c][1] * inv); o.y = cvt_pk_bf16(ot[c][2] * inv, ot[c][3] * inv); *(u32x2*)(op + 32 * c + oofs) = o; }
}

__device__ __forceinline__ void fox_ftab(const Frame& F, const float* small, const float* bfg, int h) {
    FX_LAS float* ftab = (FX_LAS float*)(F.lds + ATT_FTAB);
    FX_LAS float* wtot = (FX_LAS float*)(F.lds + ATT_FTAB + 32768);
    const float bias = bfg[h];
    int ln = F.lane; asm volatile("" : "+v"(ln));
    float v[16], run = 0.f;
#pragma unroll
    for (int k = 0; k < 16; ++k) { const float x = *(const float*)((const char*)(small + h) + (unsigned)(F.tid * 2048 + k * 128)) + bias; run += fminf(x, 0.f) - log1pf(__expf(-fabsf(x))); v[k] = run; }
    float incl = run;
#pragma unroll
    for (int o = 1; o < 64; o <<= 1) { const float t = shfl_upl(incl, o, ln); if (ln >= o) incl += t; }
    if (ln == 63) wtot[F.wave] = incl;
    __syncthreads();
    float base = incl - run;
    for (int k = 0; k < F.wave; ++k) base += wtot[k];
#pragma unroll
    for (int k = 0; k < 16; ++k) ftab[F.tid * 16 + k] = (base + v[k]) * LOG2E;
    __syncthreads();
}

__device__ __forceinline__ void phase_foxprep(const FX_CAS Args* a, const Frame& F, int l) {
    const float* gq = a->in[7] + l * 128; const float* gk = a->in[8] + l * 128;
    const int d0 = (F.lane & 15) * 8;
    float gqv[8], gkv[8];
#pragma unroll
    for (int k = 0; k < 8; ++k) { gqv[k] = gq[d0 + k] * CQK; gkv[k] = gk[d0 + k]; }
    for (int m = F.gw; m < S; m += F.NGW) {
#pragma unroll
        for (int which = 0; which < 2; ++which) {
            bf16_t* p = a->act + (size_t)m * NPAD + (which ? C_FXK : C_FXQ) + F.lane * 8;
            const u32x4 wv = *(const u32x4*)p;
            float x[8] = {bflo(wv.x), bfhi(wv.x), bflo(wv.y), bfhi(wv.y), bflo(wv.z), bfhi(wv.z), bflo(wv.w), bfhi(wv.w)};
            float ss = 0.f;
#pragma unroll
            for (int k = 0; k < 8; ++k) ss += x[k] * x[k];
            ss += shfl_xorl(ss, 1, F.lane); ss += shfl_xorl(ss, 2, F.lane); ss += shfl_xorl(ss, 4, F.lane); ss += shfl_xorl(ss, 8, F.lane);
            const float rs = rsqrtf(ss * (1.0f / 128.0f) + 1e-6f);
            u32x4 o;
            if (which) { o.x = cvt_pk_bf16(x[0] * rs * gkv[0], x[1] * rs * gkv[1]); o.y = cvt_pk_bf16(x[2] * rs * gkv[2], x[3] * rs * gkv[3]); o.z = cvt_pk_bf16(x[4] * rs * gkv[4], x[5] * rs * gkv[5]); o.w = cvt_pk_bf16(x[6] * rs * gkv[6], x[7] * rs * gkv[7]); }
            else       { o.x = cvt_pk_bf16(x[0] * rs * gqv[0], x[1] * rs * gqv[1]); o.y = cvt_pk_bf16(x[2] * rs * gqv[2], x[3] * rs * gqv[3]); o.z = cvt_pk_bf16(x[4] * rs * gqv[4], x[5] * rs * gqv[5]); o.w = cvt_pk_bf16(x[6] * rs * gqv[6], x[7] * rs * gqv[7]); }
            *(u32x4*)p = o;
        }
    }
}

__device__ __forceinline__ void phase_attn(const FX_CAS Args* a, const Frame& F, int l) {
    const int hi = blockIdx.x & 7, pi = blockIdx.x >> 3;
    for (int pr = pi; pr < 32; pr += (int)(gridDim.x >> 3)) {
        if (hi < 4) {
            attn_item<false>(F, a->act, C_SBQ, C_SBK, C_SBV, hi, 63 - pr, a->osb);
            attn_item<false>(F, a->act, C_SBQ, C_SBK, C_SBV, hi, pr, a->osb);
        } else {
            __syncthreads();
            fox_ftab(F, a->small, a->in[6] + l * 4, hi - 4);
            attn_item<true>(F, a->act, C_FXQ, C_FXK, C_FXV, hi - 4, 63 - pr, a->ofox);
            attn_item<true>(F, a->act, C_FXQ, C_FXK, C_FXV, hi - 4, pr, a->ofox);
        }
    }
    if (gridDim.x == 256) { if (hi >= 4) { ATT_BAR(); const int wf = (pi * 4 + (hi - 4)) * NWAVES + F.wave; convert_brout(a, F, l, wf, 128 * NWAVES); convert_moe(a, F, l, MOE_NA, MOE_NB, wf, 128 * NWAVES); } }
    else { ATT_BAR(); convert_brout(a, F, l, F.gw, F.NGW); }
}

constexpr int SSD_XT = 0, SSD_BT = 65536, SSD_CT = 81920, SSD_CB = 98304, SSD_DT = 114688, SSD_AC = 116736;

__device__ __forceinline__ void ssd1_item(const FX_CAS Args* a, const Frame& F, int l, int c, int grp) {
    FX_LAS unsigned char* lds = F.lds;
    FX_LAS float* dtt = (FX_LAS float*)(lds + SSD_DT); FX_LAS float* act_ = (FX_LAS float*)(lds + SSD_AC); FX_LAS float* cbm = (FX_LAS float*)(lds + SSD_CB);
    const int lane = F.lane, w = F.wave, q = lane & 15, g = lane >> 4, t0 = c * 64;
    const int h = grp * 8 + w;
    __builtin_amdgcn_sched_barrier(0); asm volatile("s_waitcnt lgkmcnt(0)" ::: "memory"); __syncthreads(); __builtin_amdgcn_sched_barrier(0);
    {
        const float x = a->small[(size_t)(t0 + lane) * 32 + 4 + h] + a->in[11][l * 16 + h];
        const float dtv = fmaxf(x, 0.f) + log1pf(__expf(-fabsf(x)));
        const float av = -__expf(a->in[12][l * 16 + h]);
        float incl = dtv * av;
#pragma unroll
        for (int o = 1; o < 64; o <<= 1) { const float t = shfl_upl(incl, o, lane); if (lane >= o) incl += t; }
        dtt[w * 64 + lane] = dtv; act_[w * 64 + lane] = incl;
        a->acum[(size_t)(t0 + lane) * 16 + h] = incl;
        if (lane == 63) a->cdec[c * 16 + h] = __expf(incl);
    }
    __syncthreads();
    {
        const float* cw = a->in[9] + (size_t)l * 4 * 1536; const float* cb = a->in[10] + (size_t)l * 1536;
#pragma unroll
        for (int pass = 0; pass < 2; ++pass) {
            if (pass == 0 || lane < 32) {
                const int ck = (pass == 0) ? lane : 64 + lane;
                const int ch = (ck < 64) ? (grp * 512 + ck * 8) : ((ck < 80) ? (1024 + grp * 128 + (ck - 64) * 8) : (1280 + grp * 128 + (ck - 80) * 8));
                u32x4 xr[11];
#pragma unroll
                for (int j = 0; j < 11; ++j) { const int tt = t0 + 8 * w - 3 + j; const u32x4 v = *(const u32x4*)(a->act + (size_t)(tt < 0 ? 0 : tt) * NPAD + C_XBC + ch); xr[j] = (tt < 0) ? (u32x4){0u, 0u, 0u, 0u} : v; }
                f32x4 wq[4][2];
#pragma unroll
                for (int wt = 0; wt < 4; ++wt) { wq[wt][0] = *(const f32x4*)(cw + wt * 1536 + ch); wq[wt][1] = *(const f32x4*)(cw + wt * 1536 + ch + 4); }
                const f32x4 b0 = *(const f32x4*)(cb + ch), b1 = *(const f32x4*)(cb + ch + 4);
#pragma unroll
                for (int tk = 0; tk < 8; ++tk) { const int lt = 8 * w + tk;
                    float acc[8];
                    acc[0] = b0[0]; acc[1] = b0[1]; acc[2] = b0[2]; acc[3] = b0[3]; acc[4] = b1[0]; acc[5] = b1[1]; acc[6] = b1[2]; acc[7] = b1[3];
#pragma unroll
                    for (int wt = 0; wt < 4; ++wt) { const u32x4 xv = xr[tk + wt]; const f32x4 w0 = wq[wt][0], w1 = wq[wt][1];
                        acc[0] += w0[0] * bflo(xv.x); acc[1] += w0[1] * bfhi(xv.x); acc[2] += w0[2] * bflo(xv.y); acc[3] += w0[3] * bfhi(xv.y);
                        acc[4] += w1[0] * bflo(xv.z); acc[5] += w1[1] * bfhi(xv.z); acc[6] += w1[2] * bflo(xv.w); acc[7] += w1[3] * bfhi(xv.w); }
                    float sc = 1.0f;
                    if (pass == 0) sc = dtt[(ck >> 3) * 64 + lt];
#pragma unroll
                    for (int k = 0; k < 8; ++k) acc[k] = silu_f(acc[k]) * sc;
                    u32x4 o; o.x = cvt_pk_bf16(acc[0], acc[1]); o.y = cvt_pk_bf16(acc[2], acc[3]); o.z = cvt_pk_bf16(acc[4], acc[5]); o.w = cvt_pk_bf16(acc[6], acc[7]);
                    if (pass == 0) *(FX_LAS u32x4*)(lds + SSD_XT + (ck >> 4) * 16384 + offV(lt, ck & 15)) = o;
                    else if (ck < 80) *(FX_LAS u32x4*)(lds + SSD_BT + offV(lt, ck - 64)) = o;
                    else { *(FX_LAS u32x4*)(lds + SSD_CT + offV(lt, ck - 80)) = o; *(u32x4*)(a->cc + (size_t)(t0 + lt) * 256 + grp * 128 + (ck - 80) * 8) = o; }
                }
            }
        }
    }
    __syncthreads();
    {
        const int mb = w >> 1;
        bf16x8 cf[4];
#pragma unroll
        for (int kk = 0; kk < 4; ++kk) cf[kk] = *(const FX_LAS bf16x8*)(lds + SSD_CT + offV(16 * mb + q, 4 * kk + g));
#pragma unroll
        for (int sbi = 0; sbi < 2; ++sbi) { const int sb = 2 * (w & 1) + sbi; f32x4 acc = (f32x4){0.f, 0.f, 0.f, 0.f};
#pragma unroll
            for (int kk = 0; kk < 4; ++kk) { const bf16x8 bfr = *(const FX_LAS bf16x8*)(lds + SSD_BT + offV(16 * sb + q, 4 * kk + g));
                acc = __builtin_amdgcn_mfma_f32_16x16x32_bf16(cf[kk], bfr, acc, 0, 0, 0); }
#pragma unroll
            for (int r = 0; r < 4; ++r) cbm[(16 * mb + 4 * g + r) * 64 + 16 * sb + q] = acc[r]; }
    }
    __syncthreads();
    const FX_LAS float* ach = act_ + w * 64; const FX_LAS float* dth = dtt + w * 64;
    FX_LAS unsigned char* xt = lds + SSD_XT + (w >> 1) * 16384;
    const int cb0 = 4 * (w & 1);
    bf16x8 xf[4][2];
#pragma unroll
    for (int pb = 0; pb < 4; ++pb)
#pragma unroll
        for (int ks = 0; ks < 2; ++ks) {
            const s16x4 v0 = __builtin_amdgcn_ds_read_tr16_b64_v4i16((FX_LAS s16x4*)(xt + trV16(lane, cb0 + pb, ks, 0)));
            const s16x4 v1 = __builtin_amdgcn_ds_read_tr16_b64_v4i16((FX_LAS s16x4*)(xt + trV16(lane, cb0 + pb, ks, 1)));
            xf[pb][ks] = __builtin_shufflevector(v0, v1, 0, 1, 2, 3, 4, 5, 6, 7); }
    {
        const float dsk = a->in[13][l * 16 + h];
#pragma unroll 1
        for (int mb = 0; mb < 4; ++mb) { const int lr = 16 * mb + q; const float al = ach[lr];
            f32x4 yd[4];
#pragma unroll
            for (int nb = 0; nb < 4; ++nb) yd[nb] = (f32x4){0.f, 0.f, 0.f, 0.f};
#pragma unroll
            for (int ks = 0; ks < 2; ++ks) { const int s0 = 32 * ks + 8 * g;
                const f32x4 c0 = *(const FX_LAS f32x4*)(cbm + lr * 64 + s0), c1 = *(const FX_LAS f32x4*)(cbm + lr * 64 + s0 + 4);
                const f32x4 a0 = *(const FX_LAS f32x4*)(ach + s0), a1 = *(const FX_LAS f32x4*)(ach + s0 + 4);
                float mv[8];
#pragma unroll
                for (int jj = 0; jj < 8; ++jj) { const float cbv = (jj < 4) ? c0[jj & 3] : c1[jj & 3], as = (jj < 4) ? a0[jj & 3] : a1[jj & 3];
                    mv[jj] = (s0 + jj <= lr) ? cbv * __expf(al - as) : 0.f; }
                u32x4 mw; mw.x = cvt_pk_bf16(mv[0], mv[1]); mw.y = cvt_pk_bf16(mv[2], mv[3]); mw.z = cvt_pk_bf16(mv[4], mv[5]); mw.w = cvt_pk_bf16(mv[6], mv[7]);
                const bf16x8 mf = __builtin_bit_cast(bf16x8, mw);
#pragma unroll
                for (int nb = 0; nb < 4; ++nb) yd[nb] = __builtin_amdgcn_mfma_f32_16x16x32_bf16(xf[nb][ks], mf, yd[nb], 0, 0, 0); }
            { const float sk = dsk / dth[lr];
#pragma unroll
                for (int nb = 0; nb < 4; ++nb) { const int col = 64 * (w & 1) + 16 * nb + 4 * g;
                    const u32x2 xw = *(const FX_LAS u32x2*)(xt + offV(lr, col >> 3) + (col & 7) * 2);
                    u32x2 o; o.x = cvt_pk_bf16(yd[nb][0] + sk * bflo(xw.x), yd[nb][1] + sk * bfhi(xw.x)); o.y = cvt_pk_bf16(yd[nb][2] + sk * bflo(xw.y), yd[nb][3] + sk * bfhi(xw.y));
                    *(u32x2*)(a->y1 + (size_t)(t0 + lr) * 1024 + h * 64 + 16 * nb + 4 * g) = o; } }
        }
    }
    {
        const float aend = ach[63];
#pragma unroll
        for (int ks = 0; ks < 2; ++ks) { const int l0 = 32 * ks + 8 * g;
            const f32x4 a0 = *(const FX_LAS f32x4*)(ach + l0), a1 = *(const FX_LAS f32x4*)(ach + l0 + 4);
            float de[8];
#pragma unroll
            for (int jj = 0; jj < 8; ++jj) de[jj] = __expf(aend - ((jj < 4) ? a0[jj & 3] : a1[jj & 3]));
#pragma unroll
            for (int pb = 0; pb < 4; ++pb) { const u32x4 xw = __builtin_bit_cast(u32x4, xf[pb][ks]); u32x4 o;
                o.x = cvt_pk_bf16(bflo(xw.x) * de[0], bfhi(xw.x) * de[1]); o.y = cvt_pk_bf16(bflo(xw.y) * de[2], bfhi(xw.y) * de[3]);
                o.z = cvt_pk_bf16(bflo(xw.z) * de[4], bfhi(xw.z) * de[5]); o.w = cvt_pk_bf16(bflo(xw.w) * de[6], bfhi(xw.w) * de[7]);
                xf[pb][ks] = __builtin_bit_cast(bf16x8, o); } }
        bf16_t* stp = a->states + ((size_t)c * 16 + h) * 64 * 128;
#pragma unroll 1
        for (int nbg = 0; nbg < 8; ++nbg) {
            f32x4 sa[4];
#pragma unroll
            for (int pb = 0; pb < 4; ++pb) sa[pb] = (f32x4){0.f, 0.f, 0.f, 0.f};
#pragma unroll
            for (int ks = 0; ks < 2; ++ks) {
                const s16x4 v0 = __builtin_amdgcn_ds_read_tr16_b64_v4i16((FX_LAS s16x4*)(lds + SSD_BT + trV16(lane, nbg, ks, 0)));
                const s16x4 v1 = __builtin_amdgcn_ds_read_tr16_b64_v4i16((FX_LAS s16x4*)(lds + SSD_BT + trV16(lane, nbg, ks, 1)));
                const bf16x8 bfr = __builtin_shufflevector(v0, v1, 0, 1, 2, 3, 4, 5, 6, 7);
#pragma unroll
                for (int pb = 0; pb < 4; ++pb) sa[pb] = __builtin_amdgcn_mfma_f32_16x16x32_bf16(bfr, xf[pb][ks], sa[pb], 0, 0, 0); }
#pragma unroll
            for (int pb = 0; pb < 4; ++pb) { u32x2 o; o.x = cvt_pk_bf16(sa[pb][0], sa[pb][1]); o.y = cvt_pk_bf16(sa[pb][2], sa[pb][3]);
                *(u32x2*)(stp + (size_t)(16 * pb + q) * 128 + 16 * nbg + 4 * g) = o; }
        }
    }
}
__device__ __forceinline__ void phase_ssd1(const FX_CAS Args* a, const Frame& F, int l) {
    for (int it = blockIdx.x; it < 256; it += gridDim.x) ssd1_item(a, F, l, it >> 1, it & 1);
}
__device__ __forceinline__ void phase_ssdscan(const FX_CAS Args* a, const Frame& F) {
    for (int idx = blockIdx.x * NTHR + F.tid; idx < 16 * 64 * 128; idx += gridDim.x * NTHR) {
        const int h = __builtin_amdgcn_readfirstlane(idx >> 13); float run = 0.f;
#pragma unroll 1
        for (int c0 = 0; c0 < 128; c0 += 16) {
            float sv[16], dv[16];
#pragma unroll
            for (int k = 0; k < 16; ++k) { sv[k] = bf2f(a->states[(size_t)(c0 + k) * 131072 + idx]); dv[k] = a->cdec[(c0 + k) * 16 + h]; }
#pragma unroll
            for (int k = 0; k < 16; ++k) { a->hin[(size_t)(c0 + k) * 131072 + idx] = (bf16_t)(cvt_pk_bf16(run, 0.f) & 0xffffu); run = run * dv[k] + sv[k]; }
        }
    }
}
__device__ __forceinline__ void ssd3_item(const FX_CAS Args* a, const Frame& F, int l, int it) {
    FX_LAS float* red = (FX_LAS float*)(F.lds);
    const int lane = F.lane, w = F.wave, q = lane & 15, g = lane >> 4;
    const int c = it >> 1;
    const float* gn = a->in[14] + l * 1024;
#pragma unroll 1
    for (int mb = 0; mb < 2; ++mb) {
        const int t0 = 64 * c + 32 * (it & 1) + 16 * mb;
        float v[2][4][4];
        float ss[4];
#pragma unroll
        for (int r = 0; r < 4; ++r) ss[r] = 0.f;
#pragma unroll
        for (int hh = 0; hh < 2; ++hh) {
            const int h = 2 * w + hh, grp = h >> 3;
            const char* hp = (const char*)(a->hin + ((size_t)c * 16 + h) * 64 * 128);
            const char* cp = (const char*)(a->cc + (size_t)t0 * 256 + grp * 128);
            const unsigned hlo = (unsigned)(q * 256 + g * 16), clo = (unsigned)(q * 512 + g * 16);
            f32x4 acc[4];
#pragma unroll
            for (int nb = 0; nb < 4; ++nb) acc[nb] = (f32x4){0.f, 0.f, 0.f, 0.f};
#pragma unroll
            for (int kk = 0; kk < 4; ++kk) {
                const bf16x8 cf = *(const bf16x8*)(cp + kk * 64 + clo);
#pragma unroll
                for (int nb = 0; nb < 4; ++nb) { const bf16x8 hf = *(const bf16x8*)(hp + nb * 4096 + kk * 64 + hlo);
                    acc[nb] = __builtin_amdgcn_mfma_f32_16x16x32_bf16(cf, hf, acc[nb], 0, 0, 0); }
            }
#pragma unroll
            for (int r = 0; r < 4; ++r) { const size_t t = (size_t)(t0 + 4 * g + r); const float ea = __expf(a->acum[t * 16 + h]);
#pragma unroll
                for (int nb = 0; nb < 4; ++nb) { const int ch = h * 64 + 16 * nb + q;
                    const float y = acc[nb][r] * ea + bf2f(a->y1[t * 1024 + ch]);
                    const float z = bf2f(a->act[t * NPAD + C_Z + ch]);
                    const float vv = y * silu_f(z); v[hh][nb][r] = vv; ss[r] += vv * vv; } }
        }
#pragma unroll
        for (int r = 0; r < 4; ++r) { float s = ss[r]; s += shfl_xorl(s, 1, lane); s += shfl_xorl(s, 2, lane); s += shfl_xorl(s, 4, lane); s += shfl_xorl(s, 8, lane); ss[r] = s; }
        __syncthreads();
        if (q == 0) {
#pragma unroll
            for (int r = 0; r < 4; ++r) red[w * 16 + 4 * g + r] = ss[r];
        }
        __syncthreads();
#pragma unroll
        for (int r = 0; r < 4; ++r) { const int tl = 4 * g + r; float tot = 0.f;
#pragma unroll
            for (int k = 0; k < 8; ++k) tot += red[k * 16 + tl];
            const float rs = rsqrtf(tot * (1.0f / 1024.0f) + 1e-6f);
#pragma unroll
            for (int hh = 0; hh < 2; ++hh)
#pragma unroll
                for (int nb = 0; nb < 4; ++nb) { const int ch = (2 * w + hh) * 64 + 16 * nb + q;
                    a->ossm[(size_t)(t0 + tl) * 2048 + ch] = (bf16_t)(cvt_pk_bf16(v[hh][nb][r] * rs * gn[ch], 0.f) & 0xffffu); } }
    }
}
__device__ __forceinline__ void phase_ssd3(const FX_CAS Args* a, const Frame& F, int l) {
    for (int it = blockIdx.x; it < 256; it += gridDim.x) ssd3_item(a, F, l, it);
}

__device__ __forceinline__ unsigned wr_off(int d, int q4) { const int r = d >> 2; return (unsigned)(((d & 3) * 512 + r) * 64 + 16 * (q4 ^ ((r >> 2) & 3))); }
constexpr int MOE_CNT = LDS_MISC + 64;

__device__ __forceinline__ void router_c0(const FX_CAS Args* a, const Frame& F, int l) {
    if (F.gw != 0) return;
    const float* shift = a->mod + (size_t)l * 6 * D + 3 * D;
    float acc[16];
#pragma unroll
    for (int e = 0; e < 16; ++e) acc[e] = 0.f;
#pragma unroll 8
    for (int d = F.lane; d < D; d += 64) { const float sh = shift[d]; const f32x4* wr = (const f32x4*)(a->in[20] + (size_t)d * 16);
#pragma unroll
        for (int q4 = 0; q4 < 4; ++q4) { const f32x4 wv = wr[q4]; acc[4 * q4] += sh * wv[0]; acc[4 * q4 + 1] += sh * wv[1]; acc[4 * q4 + 2] += sh * wv[2]; acc[4 * q4 + 3] += sh * wv[3]; } }
#pragma unroll
    for (int e = 0; e < 16; ++e) { const float t = wave_sum(acc[e]); if (F.lane == 0) a->c0[l * 16 + e] = t; }
}
constexpr int MOE_LG = LDS_MISC + 512;

template <bool XBF>
__device__ __forceinline__ void phase_router(const FX_CAS Args* a, const Frame& F, int l) {
    FX_LAS unsigned char* lds = F.lds;
    FX_LAS int* cnt = (FX_LAS int*)(lds + MOE_CNT);
    FX_LAS float* lg = (FX_LAS float*)(lds + MOE_LG) + F.wave * 64;
    const float* mod = a->mod + (size_t)l * 6 * D;
    const float* gain = a->in[19] + l * D; const float* scale = mod + 4 * D; const float* shift = mod + 3 * D;
    __syncthreads();
#pragma unroll 16
    for (int i = F.tid; i < D * 4; i += NTHR) { const int d = i >> 2, q4 = i & 3; *(FX_LAS f32x4*)(lds + wr_off(d, q4)) = *(const f32x4*)(a->in[20] + (size_t)d * 16 + q4 * 4); }
    if (F.tid < 16) cnt[F.tid] = 0;
    __syncthreads();
    const unsigned wbase = (unsigned)(F.lane * 64), wsw = (unsigned)((F.lane >> 2) & 3);
    const int lane = F.lane;
    for (int blk = blockIdx.x; blk < S / 32; blk += gridDim.x) {
        const int m0 = blk * 32 + F.wave * 4;
        const f32x4* xr = (const f32x4*)(a->in[0] + (size_t)m0 * D) + lane;
        const u32x2* xb = (const u32x2*)(a->xbuf + (size_t)m0 * D) + lane;
#define RT_LOADX(dst, idx) do { if (XBF) { const u32x2 _v = xb[idx]; dst = (f32x4){bflo(_v.x), bfhi(_v.x), bflo(_v.y), bfhi(_v.y)}; } else dst = xr[idx]; } while (0)
        const u32x2* dr = (const u32x2*)(a->osb + (size_t)m0 * D) + lane;
        float acc[64], ss[4];
#pragma unroll
        for (int i = 0; i < 64; ++i) acc[i] = 0.f;
#pragma unroll
        for (int r = 0; r < 4; ++r) ss[r] = 0.f;
#pragma unroll 1
        for (int j = 0; j < 8; ++j) {
            const f32x4 gg = ((const f32x4*)gain)[lane + 64 * j], sc = ((const f32x4*)scale)[lane + 64 * j];
            f32x4 x[4];
#pragma unroll
            for (int r = 0; r < 4; ++r) { RT_LOADX(x[r], r * (D / 4) + 64 * j); { const u32x2 dv = dr[r * (D / 4) + 64 * j]; x[r][0] += bflo(dv.x); x[r][1] += bfhi(dv.x); x[r][2] += bflo(dv.y); x[r][3] += bfhi(dv.y); } ss[r] += (x[r][0] * x[r][0] + x[r][1] * x[r][1]) + (x[r][2] * x[r][2] + x[r][3] * x[r][3]); }
#pragma unroll
            for (int k = 0; k < 4; ++k) { const float G = gg[k] * (1.0f + sc[k]);
#pragma unroll
                for (int q4 = 0; q4 < 4; ++q4) { const f32x4 wv = *(const FX_LAS f32x4*)(lds + k * 32768 + j * 4096 + wbase + 16u * ((unsigned)q4 ^ wsw));
#pragma unroll
                    for (int r = 0; r < 4; ++r) { const float u = x[r][k] * G;
                        acc[r * 16 + 4 * q4 + 0] += u * wv[0]; acc[r * 16 + 4 * q4 + 1] += u * wv[1]; acc[r * 16 + 4 * q4 + 2] += u * wv[2]; acc[r * 16 + 4 * q4 + 3] += u * wv[3]; } } }
        }
        float rs[4];
#pragma unroll
        for (int r = 0; r < 4; ++r) rs[r] = rsqrtf(wave_sum(ss[r]) * (1.0f / D) + 1e-6f);
#pragma unroll 1
        for (int j = 0; j < 8; ++j) {
            const f32x4 gg = ((const f32x4*)gain)[lane + 64 * j], sc = ((const f32x4*)scale)[lane + 64 * j], sh = ((const f32x4*)shift)[lane + 64 * j];
#pragma unroll
            for (int r = 0; r < 4; ++r) { f32x4 x; RT_LOADX(x, r * (D / 4) + 64 * j); { const u32x2 dv = dr[r * (D / 4) + 64 * j]; x[0] += bflo(dv.x); x[1] += bfhi(dv.x); x[2] += bflo(dv.y); x[3] += bfhi(dv.y); } float h[4];
#pragma unroll
                for (int k = 0; k < 4; ++k) h[k] = x[k] * rs[r] * (gg[k] * (1.0f + sc[k])) + sh[k];
                u32x2 wv; wv.x = cvt_pk_bf16(h[0], h[1]); wv.y = cvt_pk_bf16(h[2], h[3]);
                ((u32x2*)(a->hb + (size_t)(m0 + r) * D))[lane + 64 * j] = wv; }
        }
        {
            const int ln = fx_lane();
#pragma unroll
            for (int m = 32, n = 64; m >= 1; m >>= 1, n >>= 1) { const bool hi = (ln & m) != 0;
#pragma unroll
                for (int i = 0; i < 32; ++i) if (i < n / 2) { const float snd = hi ? acc[i] : acc[i + n / 2], kp = hi ? acc[i + n / 2] : acc[i]; acc[i] = kp + shfl_xorl(snd, m, ln); } }
            const int rr = ln >> 4; const float rsel = (rr == 0) ? rs[0] : ((rr == 1) ? rs[1] : ((rr == 2) ? rs[2] : rs[3]));
            lg[ln] = acc[0] * rsel + a->c0[l * 16 + (ln & 15)];
        }
        asm volatile("s_waitcnt lgkmcnt(0)" ::: "memory");
        if (lane < 4) {
            const int r = lane; float aff[16], sel[16];
#pragma unroll
            for (int e = 0; e < 16; ++e) { const float v = lg[r * 16 + e]; aff[e] = 1.0f / (1.0f + __expf(-v)); sel[e] = aff[e] + a->in[21][e]; }
            int bg = 0; float bs = -1e30f;
#pragma unroll
            for (int gI = 0; gI < 4; ++gI) { float m1 = -1e30f, m2 = -1e30f;
#pragma unroll
                for (int jx = 0; jx < 4; ++jx) { const float v = sel[gI * 4 + jx]; if (v > m1) { m2 = m1; m1 = v; } else if (v > m2) m2 = v; }
                const float sc2 = m1 + m2; if (sc2 > bs) { bs = sc2; bg = gI; } }
            int i1 = 0, i2 = 0; float m1 = -1e30f, m2 = -1e30f, a1 = 0.f, a2 = 0.f;
#pragma unroll
            for (int e = 0; e < 16; ++e) { if ((e >> 2) == bg) { const float v = sel[e];
                    if (v > m1) { m2 = m1; i2 = i1; a2 = a1; m1 = v; i1 = e; a1 = aff[e]; } else if (v > m2) { m2 = v; i2 = e; a2 = aff[e]; } } }
            const int m = m0 + r; const float inv = 1.0f / (a1 + a2);
            a->eidx[m * 2] = i1; a->eidx[m * 2 + 1] = i2; a->wsel[m * 2] = a1 * inv; a->wsel[m * 2 + 1] = a2 * inv;
            __hip_atomic_fetch_add((int*)(cnt + i1), 1, __ATOMIC_RELAXED, __HIP_MEMORY_SCOPE_WORKGROUP); __hip_atomic_fetch_add((int*)(cnt + i2), 1, __ATOMIC_RELAXED, __HIP_MEMORY_SCOPE_WORKGROUP);
        }
        __syncthreads();
        if (F.tid < 16) { a->cntb[blk * 16 + F.tid] = cnt[F.tid]; cnt[F.tid] = 0; }
        __syncthreads();
    }
}
#undef RT_LOADX
__device__ __forceinline__ void phase_lists(const FX_CAS Args* a, const Frame& F) {
    FX_LAS int* tot = (FX_LAS int*)(F.lds + MOE_CNT); FX_LAS int* pre = tot + 16; FX_LAS int* base = tot + 32;
    FX_LAS int* ev = (FX_LAS int*)(F.lds);
    for (int blk = blockIdx.x; blk < S / 32; blk += gridDim.x) {
        __syncthreads();
        if (F.tid < 32) tot[F.tid] = 0;
        if (F.tid < 64) ev[F.tid] = a->eidx[blk * 64 + F.tid];
        __syncthreads();
        {
            const int ln = fx_lane(); int t = 0, p = 0;
#pragma unroll
            for (int k = 0; k < (S / 32) / 32; ++k) { const int cv = a->cntb[F.tid + 512 * k]; t += cv; p += (((F.tid >> 4) + 32 * k) < blk) ? cv : 0; }
            t += __builtin_amdgcn_ds_bpermute((ln ^ 16) << 2, t); p += __builtin_amdgcn_ds_bpermute((ln ^ 16) << 2, p); t += __builtin_amdgcn_ds_bpermute((ln ^ 32) << 2, t); p += __builtin_amdgcn_ds_bpermute((ln ^ 32) << 2, p);
            if (ln < 16) { __hip_atomic_fetch_add((int*)(tot + ln), t, __ATOMIC_RELAXED, __HIP_MEMORY_SCOPE_WORKGROUP); __hip_atomic_fetch_add((int*)(pre + ln), p, __ATOMIC_RELAXED, __HIP_MEMORY_SCOPE_WORKGROUP); }
        }
        __syncthreads();
        if (F.tid == 0) { int tb = 0; for (int e = 0; e < 16; ++e) { base[e] = tb * 256; if (blk == 0) a->tbase[e] = tb; tb += (tot[e] + 255) >> 8; } if (blk == 0) a->tbase[16] = tb; }
        __syncthreads();
        if (F.tid < 64) { const int i = F.tid, e = ev[i]; int rank = 0;
#pragma unroll
            for (int q = 0; q < NE; ++q) { const unsigned long long mk = __builtin_amdgcn_ballot_w64(e == q); const int below = (int)__builtin_amdgcn_mbcnt_hi((unsigned)(mk >> 32), __builtin_amdgcn_mbcnt_lo((unsigned)mk, 0u)); if (e == q) rank = below; }
            const int pos = base[e] + pre[e] + rank, m = blk * 32 + (i >> 1); a->slot[m * 2 + (i & 1)] = pos; a->list[pos] = m; }
        if (blk < 16) { const int e = blk; const int n = tot[e], cap = ((n + 255) >> 8) * 256; for (int i = n + F.tid; i < cap; i += NTHR) a->list[base[e] + i] = 0; }
    }
}
constexpr int MOE_DEP = 131072;
__device__ __forceinline__ void phase_gateup(const FX_CAS Args* a, const Frame& F, int l) {
    Gemm g{a->hb, a->w_gu_t + (size_t)l * NE * D * D, D, (size_t)D * D * 2, a->list, a->ctl + MOE_DEP + l * 128}; MoeOrder Mo{a->tbase, F.G, (int)blockIdx.x, D / BK};
    EpiGateUp E{a->actb};
    gemm_phase<EpiGateUp, MoeOrder, true, 1>(F.lds, F.tid, g, Mo, E);
}
__device__ __forceinline__ void phase_down(const FX_CAS Args* a, const Frame& F, int l) {
    Gemm g{a->actb, a->w_d_t + (size_t)l * NE * D * FF, FF, (size_t)D * FF * 2, nullptr, a->ctl + MOE_DEP + l * 128}; DownOrder Mo{a->tbase, F.G, (int)blockIdx.x, FF / BK};
    EpiDown E{a->ybuf};
    gemm_phase<EpiDown, DownOrder, false, 2>(F.lds, F.tid, g, Mo, E);
}
#ifndef DUP_PRO
#define DUP_PRO 0
#endif
#ifndef DUP_INPROJ
#define DUP_INPROJ 0
#endif
#ifndef DUP_ATTN
#define DUP_ATTN 0
#endif
#ifndef DUP_MOE
#define DUP_MOE 0
#endif
#ifndef DUP_BRANCH
#define DUP_BRANCH 0
#endif
#ifndef DUP_SSD
#define DUP_SSD 0
#endif
#ifndef DUP_ROUTER
#define DUP_ROUTER 0
#endif
#ifndef DUP_THIN
#define DUP_THIN 0
#endif

enum { PH_PRO = 0, PH_NORMA = 1, PH_INPROJ = 2, PH_BRANCH = 3, PH_OUT = 4, PH_FOXPREP = 5, PH_ATTN = 6, PH_SSD1 = 7, PH_SSDSCAN = 8, PH_SSD3 = 9,
       PH_ROUTER = 10, PH_LISTS = 11, PH_GATEUP = 12, PH_DOWN = 13, PH_NORMC = 14, PH_FINAL = 15 };

__device__ __forceinline__ Frame make_frame(unsigned char* lds) {
    Frame F; F.lds = (FX_LAS unsigned char*)lds; F.tid = threadIdx.x; F.lane = F.tid & 63; F.wave = __builtin_amdgcn_readfirstlane(F.tid >> 6);
    F.G = gridDim.x; F.gw = blockIdx.x * NWAVES + F.wave; F.NGW = F.G * NWAVES; return F;
}
template <int PH>
__device__ __forceinline__ void run_phase(const FX_CAS Args* a0, const Frame& F0, int l) {
    Frame F = F0; F.lane = (int)__builtin_amdgcn_mbcnt_hi(~0u, __builtin_amdgcn_mbcnt_lo(~0u, 0u)); asm volatile("" : "+v"(F.lane)); F.tid = F.wave * 64 + F.lane;
    const FX_CAS Args* a = a0; asm volatile("" : "+s"(a));
    const float* mod = a->mod + (size_t)l * 6 * D;
    if constexpr (PH == PH_PRO) phase_prologue(a, F);
    if constexpr (PH == PH_NORMA || PH == PH_NORMC) router_c0(a, F, l);
    if constexpr (PH == PH_NORMA) phase_normmod<false, true>(F, a->in[0], nullptr, nullptr, nullptr, nullptr, nullptr, nullptr, a->in[4] + l * D, mod + D, mod, a->hb);
    if constexpr (PH == PH_NORMC) phase_normmod<true, true, false, true>(F, a->in[0], a->xbuf, mod - D, a->ybuf, a->slot, a->wsel, a->osb, a->in[4] + l * D, mod + D, mod, a->hb);
    if constexpr (PH == PH_NORMC) convert_in1(a, F);
    if constexpr (PH == PH_FINAL) phase_normmod<true, false, true, false>(F, a->xbuf, a->out, mod + 5 * D, a->ybuf, a->slot, a->wsel, a->osb, nullptr, nullptr, nullptr, nullptr);
    if constexpr (PH == PH_INPROJ) {
        Gemm g{a->hb, a->w_in_t + (size_t)l * NPAD * D, D, 0, nullptr}; StaticOrder So; So.init(S, NPAD, D, F.G, (int)blockIdx.x);
        EpiInProj E{a->act, a->small};
        gemm_phase<EpiInProj, StaticOrder, false>(F.lds, F.tid, g, So, E);
        if (gridDim.x == 256 && blockIdx.x >= 224) convert_moe(a, F, l, 0, MOE_NA, (int)(blockIdx.x - 224) * NWAVES + F.wave, 32 * NWAVES);
    }
    if constexpr (PH == PH_BRANCH) phase_branch(a, F, l);
    if constexpr (PH == PH_OUT) phase_out(a, F, l);
    if constexpr (PH == PH_FOXPREP) phase_foxprep(a, F, l);
    if constexpr (PH == PH_ATTN) phase_attn(a, F, l);
    if constexpr (PH == PH_SSD1) phase_ssd1(a, F, l);
    if constexpr (PH == PH_SSDSCAN) phase_ssdscan(a, F);
    if constexpr (PH == PH_SSD3) phase_ssd3(a, F, l);
    if constexpr (PH == PH_ROUTER) { if (l == 0) phase_router<false>(a, F, l); else phase_router<true>(a, F, l); }
    if constexpr (PH == PH_LISTS) phase_lists(a, F);
    if constexpr (PH == PH_GATEUP) phase_gateup(a, F, l);
    if constexpr (PH == PH_DOWN) phase_down(a, F, l);
}
__global__ void __launch_bounds__(NTHR, 2) mega_fwd(Args a_unused) {
    extern __shared__ __attribute__((aligned(16))) unsigned char lds_raw[];
    const Frame F = make_frame(lds_raw);
    const FX_CAS Args* a = (const FX_CAS Args*)__builtin_amdgcn_kernarg_segment_ptr();
    volatile FX_LAS unsigned* misc = (volatile FX_LAS unsigned*)(F.lds + LDS_MISC);
    if (F.tid < 64) misc[F.tid] = 0u;
    __syncthreads();
    const XcdBarrier bar = xcd_barrier_post(a->ctl + 4096, misc, F.wave);
    run_phase<PH_PRO>(a, F, 0);
    xcd_barrier(bar);
    if (DUP_PRO) { run_phase<PH_PRO>(a, F, 0); xcd_barrier(bar); }
#define FX_LAYER(l, NORMPH) do { \
        run_phase<NORMPH>(a, F, l); xcd_barrier(bar); \
        run_phase<PH_INPROJ>(a, F, l); xcd_barrier(bar); \
        if (DUP_INPROJ) { run_phase<PH_INPROJ>(a, F, l); xcd_barrier(bar); } \
        run_phase<PH_FOXPREP>(a, F, l); run_phase<PH_SSD1>(a, F, l); xcd_barrier(bar); \
        if (DUP_SSD) { run_phase<PH_SSD1>(a, F, l); xcd_barrier(bar); } \
        run_phase<PH_SSDSCAN>(a, F, l); xcd_barrier(bar); \
        if (DUP_SSD) { run_phase<PH_SSDSCAN>(a, F, l); xcd_barrier(bar); run_phase<PH_SSD3>(a, F, l); xcd_barrier(bar); } \
        run_phase<PH_SSD3>(a, F, l); run_phase<PH_ATTN>(a, F, l); xcd_barrier(bar); \
        if (DUP_ATTN) { run_phase<PH_ATTN>(a, F, l); xcd_barrier(bar); } \
        run_phase<PH_BRANCH>(a, F, l); xcd_barrier(bar); \
        if (DUP_BRANCH) { run_phase<PH_BRANCH>(a, F, l); xcd_barrier(bar); } \
        run_phase<PH_OUT>(a, F, l); xcd_barrier(bar); \
        run_phase<PH_ROUTER>(a, F, l); xcd_barrier(bar); \
        run_phase<PH_LISTS>(a, F, l); xcd_barrier(bar); \
        if (DUP_ROUTER) { run_phase<PH_ROUTER>(a, F, l); xcd_barrier(bar); run_phase<PH_LISTS>(a, F, l); xcd_barrier(bar); } \
        run_phase<PH_GATEUP>(a, F, l); \
        run_phase<PH_DOWN>(a, F, l); xcd_barrier(bar); \
        } while (0)
    FX_LAYER(0, PH_NORMA);
    FX_LAYER(1, PH_NORMC);
#undef FX_LAYER
    if (DUP_THIN) { for (int i = 0; i < 10; ++i) xcd_barrier(bar); }
    run_phase<PH_FINAL>(a, F, 1);
}
static bool carve(Args& a, void* const* d_in, void* d_out, void* d_ws, size_t ws_size) {
    for (int i = 0; i < 25; ++i) a.in[i] = (const float*)d_in[i];
    a.out = (float*)d_out;
    unsigned char* ws = (unsigned char*)d_ws; size_t o = 0;
    auto take = [&](size_t bytes) { unsigned char* p = ws + o; o += (bytes + 255) & ~(size_t)255; return p; };
    a.ctl = (unsigned*)take(1 << 20);
    a.mod = (float*)take(2 * 6 * D * 4);
    a.w_in_t = (bf16_t*)take((size_t)2 * NPAD * D * 2);
    a.w_br_t = (bf16_t*)take((size_t)2 * D * D * 2); a.w_out_t = (bf16_t*)take((size_t)2 * D * D * 2);
    a.w_gu_t = (bf16_t*)take((size_t)2 * NE * D * D * 2); a.w_d_t = (bf16_t*)take((size_t)2 * NE * D * FF * 2);
    a.act = (bf16_t*)take((size_t)S * NPAD * 2);
    a.small = (float*)take((size_t)S * 32 * 4);
    a.hb = (bf16_t*)take((size_t)S * D * 2);
    a.osb = (bf16_t*)take((size_t)S * 2048 * 2); a.ofox = a.osb + 512; a.ossm = a.osb + 1024;
    a.merged = (bf16_t*)take((size_t)S * D * 2);
    a.xbuf = (bf16_t*)take((size_t)S * D * 2);
    a.states = (bf16_t*)take((size_t)128 * 131072 * 2); a.hin = (bf16_t*)take((size_t)128 * 131072 * 2); a.y1 = (bf16_t*)take((size_t)S * 1024 * 2);
    a.cc = (bf16_t*)take((size_t)S * 256 * 2); a.acum = (float*)take((size_t)S * 16 * 4); a.cdec = (float*)take(128 * 16 * 4);
    a.eidx = (int*)take((size_t)S * 2 * 4); a.wsel = (float*)take((size_t)S * 2 * 4); a.slot = (int*)take((size_t)S * 2 * 4); a.list = (int*)take((size_t)SLOTCAP * 4);
    a.cntb = (int*)take(256 * 16 * 4); a.tbase = (int*)take(256); a.c0 = (float*)take(256);
    a.actb = (bf16_t*)take((size_t)SLOTCAP * FF * 2); a.ybuf = (bf16_t*)take((size_t)SLOTCAP * D * 2);
    return o <= ws_size;
}
}

extern "C" void kernel_launch(void* const* d_in, const int* in_sizes, int n_in, void* d_out, int out_size, void* d_ws, size_t ws_size, hipStream_t stream) {
    (void)in_sizes; (void)n_in; (void)out_size;
    static int grid = 0;
    if (grid == 0) {
        int dev = 0, cus = 0;
        if (hipGetDevice(&dev) != hipSuccess || hipDeviceGetAttribute(&cus, hipDeviceAttributeMultiprocessorCount, dev) != hipSuccess) { grid = -1; return; }
        if (hipFuncSetAttribute((const void*)fx::mega_fwd, hipFuncAttributeMaxDynamicSharedMemorySize, fx::LDS_BYTES) != hipSuccess) { grid = -1; return; }
        grid = cus > 256 ? 256 : cus;
    }
    if (grid < 0) return;
    fx::Args a{};
    if (!fx::carve(a, d_in, d_out, d_ws, ws_size)) return;
    (void)hipMemsetAsync(a.ctl, 0, 1 << 20, stream);
    hipLaunchKernelGGL(fx::mega_fwd, dim3(grid), dim3(fx::NTHR), fx::LDS_BYTES, stream, a);
}
```

```cpp
#include <hip/hip_runtime.h>
#include <stdint.h>
#include <stddef.h>


namespace fx {
#define FX_LAS __attribute__((address_space(3)))
#define FX_CAS __attribute__((address_space(4)))
typedef unsigned short bf16_t;
typedef short bf16x8 __attribute__((ext_vector_type(8)));
typedef short s16x4 __attribute__((ext_vector_type(4)));
typedef float f32x4 __attribute__((ext_vector_type(4)));
typedef float f32x2 __attribute__((ext_vector_type(2)));
typedef unsigned u32x4 __attribute__((ext_vector_type(4)));
typedef unsigned u32x2 __attribute__((ext_vector_type(2)));

constexpr int S = 8192, D = 2048, NP = 11796, NPAD = 12032, NE = 16, FF = 1024;
constexpr int C_SBQ = 0, C_SBK = 512, C_SBV = 1024, C_FXQ = 1536, C_FXK = 2048, C_FXV = 2560, C_Z = 3072, C_XBC = 4096, C_GATE = 5632, C_SMALL = 11776;
constexpr float CQK = 0.08838834764831845f * 1.4426950408889634f;
constexpr float LOG2E = 1.4426950408889634f;
constexpr int NWAVES = 8, NTHR = 512;
constexpr int SLOTCAP = 20480;
constexpr int LDS_BYTES = 147456;
constexpr int LDS_MISC = 139264;

typedef __bf16 fx_bf2 __attribute__((ext_vector_type(2))); typedef float fx_f2 __attribute__((ext_vector_type(2)));
__device__ __forceinline__ unsigned cvt_pk_bf16(float lo, float hi) { const fx_f2 v = {lo, hi}; const fx_bf2 b = __builtin_convertvector(v, fx_bf2); return __builtin_bit_cast(unsigned, b); }
__device__ __forceinline__ float bf2f(unsigned short b) { return __uint_as_float(((unsigned)b) << 16); }
__device__ __forceinline__ float bflo(unsigned w) { return __uint_as_float(w << 16); }
__device__ __forceinline__ float bfhi(unsigned w) { return __uint_as_float(w & 0xffff0000u); }
__device__ __forceinline__ float fast_exp2(float x) { return __builtin_amdgcn_exp2f(x); }
__device__ __forceinline__ float fast_rcp(float x) { return __builtin_amdgcn_rcpf(x); }
__device__ __forceinline__ float sigmoid_f(float x) { return fast_rcp(1.0f + fast_exp2(-x * LOG2E)); }
__device__ __forceinline__ float silu_f(float x) { return x * sigmoid_f(x); }
__device__ __forceinline__ int fx_lane() { int l = (int)__builtin_amdgcn_mbcnt_hi(~0u, __builtin_amdgcn_mbcnt_lo(~0u, 0u)); asm volatile("" : "+v"(l)); return l; }
__device__ __forceinline__ float shfl_idx(float v, int src) { return __int_as_float(__builtin_amdgcn_ds_bpermute(src << 2, __float_as_int(v))); }
__device__ __forceinline__ float shfl_xorl(float v, int m, int lane) { return shfl_idx(v, lane ^ m); }
__device__ __forceinline__ float shfl_upl(float v, int d, int lane) { return shfl_idx(v, lane >= d ? lane - d : lane); }
__device__ __forceinline__ float wave_sum(float v) {
    const int lane = fx_lane();
#pragma unroll
    for (int o = 1; o < 64; o <<= 1) v += shfl_xorl(v, o, lane);
    return v;
}

#define XB_TMO      128
#define XB_XCNT(j)  (256  + 64 * (j))
#define XB_XSUB(j)  (1280 + 64 * (j))
#define XB_XGEN(j)  (2304 + 64 * (j))
#define XB_TOP      3328
#define XB_TOPGEN   3392
#define XCD_BAR_WORDS 3456
#define XB_SPIN_CAP (1u << 18)
__device__ __forceinline__ unsigned xb_ld(unsigned* p)              { return __hip_atomic_load(p, __ATOMIC_RELAXED, __HIP_MEMORY_SCOPE_AGENT); }
__device__ __forceinline__ unsigned xb_add(unsigned* p, unsigned v) { return __hip_atomic_fetch_add(p, v, __ATOMIC_RELAXED, __HIP_MEMORY_SCOPE_AGENT); }
__device__ __forceinline__ unsigned xb_xcc_id() { return (unsigned)__builtin_amdgcn_s_getreg((3 << 11) | 20) & 0xFu; }
#define XB_SPIN(cond, bar) do { unsigned _sp = 0; while (cond) { __builtin_amdgcn_s_sleep(1); \
    if ((++_sp & 255u) == 0u) { if (xb_ld(&(bar)[XB_TMO])) break; if (_sp > XB_SPIN_CAP) { atomicAdd(&(bar)[XB_TMO], 1u); break; } } } } while (0)
struct XcdBarrier { unsigned* bar; unsigned x; volatile FX_LAS unsigned* st; int wave; };
__device__ __forceinline__ bool xb_leader(int wave) { return wave == 0 && __builtin_amdgcn_mbcnt_hi(~0u, __builtin_amdgcn_mbcnt_lo(~0u, 0u)) == 0u; }
__device__ __forceinline__ XcdBarrier xcd_barrier_post(unsigned* bar, volatile FX_LAS unsigned* st, int wave) {
    XcdBarrier b; b.bar = bar; b.x = xb_xcc_id(); b.st = st; b.wave = wave;
    if (xb_leader(wave)) (void)xb_add(&bar[XB_XCNT(b.x)], 1u);
    return b;
}
__device__ __forceinline__ void xcd_barrier_complete(unsigned* bar, unsigned x, unsigned& nloc, unsigned& nx) {
    const unsigned G = gridDim.x * gridDim.y * gridDim.z;
    unsigned sum, cnt, mine, sp = 0u;
    for (;;) {
        sum = 0u; cnt = 0u; mine = 0u;
#pragma unroll
        for (unsigned j = 0; j < 16; ++j) { const unsigned c = xb_ld(&bar[XB_XCNT(j)]); sum += c; cnt += (c > 0u) ? 1u : 0u; mine = (j == x) ? c : mine; }
        if (sum == G) break;
        __builtin_amdgcn_s_sleep(1);
        if ((++sp & 255u) == 0u) { if (xb_ld(&bar[XB_TMO])) break; if (sp > XB_SPIN_CAP) { atomicAdd(&bar[XB_TMO], 1u); break; } }
    }
    nloc = mine > 0u ? mine : 1u; nx = cnt > 0u ? cnt : 1u;
}
__device__ __forceinline__ void xcd_barrier(const XcdBarrier& b) {
    asm volatile("s_waitcnt vmcnt(0)" ::: "memory");
    __syncthreads();
    if (xb_leader(b.wave)) {
        unsigned* bar = b.bar; asm volatile("" : "+s"(bar));
        __builtin_amdgcn_s_waitcnt(0);
        unsigned nloc = b.st[0], nx = b.st[1];
        if (nloc == 0u) { xcd_barrier_complete(bar, b.x, nloc, nx); b.st[0] = nloc; b.st[1] = nx; }
        const unsigned old = xb_add(&bar[XB_XSUB(b.x)], 1u);
        const unsigned gen = old / nloc;
        if (old + 1u == (gen + 1u) * nloc) {
            __builtin_amdgcn_fence(__ATOMIC_RELEASE, "agent");
            asm volatile("s_waitcnt vmcnt(0)" ::: "memory");
            const unsigned og = xb_add(&bar[XB_TOP], 1u);
            const unsigned tg = og / nx;
            if (og + 1u == (tg + 1u) * nx) xb_add(&bar[XB_TOPGEN], 1u);
            else XB_SPIN(xb_ld(&bar[XB_TOPGEN]) == tg, bar);
            __builtin_amdgcn_fence(__ATOMIC_ACQUIRE, "agent");
            xb_add(&bar[XB_XGEN(b.x)], 1u);
            asm volatile("s_waitcnt vmcnt(0)" ::: "memory");
        } else {
            XB_SPIN(xb_ld(&bar[XB_XGEN(b.x)]) == gen, bar);
            __builtin_amdgcn_fence(__ATOMIC_ACQUIRE, "agent");
            asm volatile("s_waitcnt vmcnt(0)" ::: "memory");
        }
    }
    __syncthreads();
}

struct Args {
    const float* in[25];
    float* out;
    unsigned* ctl;
    float* mod;
    bf16_t *w_in_t, *w_br_t, *w_out_t, *w_gu_t, *w_d_t;
    bf16_t* act;
    float* small;
    bf16_t* hb;
    bf16_t* xbuf;
    const float* xin;
    bf16_t *osb, *ofox, *ossm;
    bf16_t* merged;
    float* ft;
    bf16_t* states;
    bf16_t* hin;
    bf16_t* y1;
    bf16_t* cc;
    float* acum;
    float* cdec;
    int* eidx; float* wsel; int* slot; int* list; int* cntb; int* tbase;
    float* c0;
    bf16_t* actb;
    bf16_t* ybuf;
    int layer_lo, layer_hi, ph_lo, ph_hi;
};

constexpr int BM = 256, BK = 64, HALF = 128, HTB = HALF * BK * 2, STAGE_BYTES = 8 * HTB, NXCD = 8, WGM = 8;
__host__ __device__ __forceinline__ int lds_byte(int r, int c) { const int st = (r >> 4) * 2 + (c >> 5), rr = r & 15, cc = c & 31, ob = rr * 64 + cc * 2; return st * 1024 + (ob ^ (((ob >> 9) & 1) << 5)); }
__host__ __device__ __forceinline__ void stage_rc(int b, int& R, int& C) { const int st = b / 1024, sb = b % 1024, swz = sb ^ (((sb >> 9) & 1) << 5); R = (st >> 1) * 16 + swz / 64; C = (st & 1) * 32 + (swz % 64) / 2; }
__host__ __device__ __forceinline__ int perm32(int rho) { const int n = rho >> 4, i = rho & 15; return 8 * (i >> 2) + 4 * n + (i & 3); }

struct Unit { int pm, pn, e, kofs, nt; };
struct Gemm { const bf16_t* A; const bf16_t* Bt; int K; size_t bstride; const int* rows; unsigned* dep = nullptr; };

struct StaticOrder {
    int nM, nN, nwg, G, c, nt;
    __device__ void init(int M, int N, int K, int G_, int c_) { nM = M / BM; nN = N / BM; nwg = nM * nN; G = G_; c = c_; nt = K / BK; }
    __device__ bool next(int i, Unit& u) const {
        const long L = (long)i * G + c; if (L >= nwg) return false;
        int wgid = (int)L; { const int q = nwg / NXCD, r = nwg % NXCD, xcd = wgid % NXCD, off = wgid / NXCD; wgid = (xcd < r ? xcd * (q + 1) : r * (q + 1) + (xcd - r) * q) + off; }
        const int nig = WGM * nN, gid = wgid / nig, fm = gid * WGM, gsz = (nM - fm) < WGM ? (nM - fm) : WGM;
        u.pm = fm + ((wgid % nig) % gsz); u.pn = (wgid % nig) / gsz; u.e = 0; u.kofs = 0; u.nt = nt; return true;
    }
};
struct MoeOrder {
    const int* tb; int G, c, nt;
    __device__ bool next(int i, Unit& u) const {
        const int L = i * G + c; const int mt = L >> 3;
        if (mt >= tb[16]) return false;
        int e = 0;
#pragma unroll
        for (int k = 1; k < 16; ++k) e += (mt >= tb[k]) ? 1 : 0;
        u.pm = mt; u.pn = L & 7; u.e = e; u.kofs = 0; u.nt = nt; return true;
    }
};

struct DownOrder {
    const int* tb; int G, c, nt;
    __device__ bool next(int i, Unit& u) const {
        const int T = tb[16], NU = 8 * T, H = NU % G, nl = G - H;
        int d;
        if (H == 0) d = i * G + c;
        else if (c >= H) d = (i < 2) ? i * nl + (c - H) : 2 * nl + (i - 2) * G + c;
        else d = 2 * nl + i * G + c;
        if (d >= NU) return false;
        const int mt = d >> 3; int e = 0;
#pragma unroll
        for (int k = 1; k < 16; ++k) e += (mt >= tb[k]) ? 1 : 0;
        u.pm = mt; u.pn = d & 7; u.e = e; u.kofs = 0; u.nt = nt; return true;
    }
};
template <class Epi, class Sched, bool GATHER, int DEP = 0>
__device__ __forceinline__ void gemm_phase(FX_LAS unsigned char* lds, const int tid, const Gemm g, const Sched& S, const Epi& E) {
    const int wid = __builtin_amdgcn_readfirstlane(tid >> 6), lane = tid & 63, wr = wid >> 2, wc = wid & 3, fr = lane & 15, fq = lane >> 4;
    const int K = g.K;
    int Rr[2], Cc[2]; unsigned voffB[2];
#pragma unroll
    for (int i = 0; i < 2; ++i) { int R, C; stage_rc(tid * 16 + i * 8192, R, C); const int Rb = Epi::PERM ? ((R & ~31) + perm32(R & 31)) : R; Rr[i] = R; Cc[i] = C; voffB[i] = (unsigned)(Rb * K + C) * 2u; }
    const size_t kstep = (size_t)(BK * 2);
    const size_t hstep = (size_t)HALF * K * 2;
    const size_t tstep = 2 * hstep;
    const unsigned ldsw = (unsigned)wid * 1024u;
    const int aoff = lds_byte(wr * 64 + fr, fq * 8), boff = lds_byte(wc * 32 + fr, fq * 8);
#define PG8_SA(b, h) (((b) * 2 + (h)) * HTB)
#define PG8_SB(b, h) ((4 + (b) * 2 + (h)) * HTB)
#define PG8_STAGE(bufoff, gbase, voff) do { _Pragma("unroll") for (int _i = 0; _i < 2; ++_i) \
        __builtin_amdgcn_global_load_lds((const unsigned*)((const char*)(gbase) + (voff)[_i]), (FX_LAS unsigned*)(lds + (bufoff) + ldsw + _i * 8192), 16, 0, 0); } while (0)
#define PG8_LDA(dst, b, h) do { _Pragma("unroll") for (int m = 0; m < 4; ++m) _Pragma("unroll") for (int k = 0; k < 2; ++k) dst[m][k] = *(const FX_LAS bf16x8*)(lds + PG8_SA(b, h) + aoff + m * 2048 + k * 1024); } while (0)
#define PG8_LDB(dst, b, h) do { _Pragma("unroll") for (int n = 0; n < 2; ++n) _Pragma("unroll") for (int k = 0; k < 2; ++k) dst[n][k] = *(const FX_LAS bf16x8*)(lds + PG8_SB(b, h) + boff + n * 2048 + k * 1024); } while (0)
#define PG8_MMA(ai, bj, At, Bt) do { __builtin_amdgcn_s_setprio(1); _Pragma("unroll") for (int m = 0; m < 4; ++m) _Pragma("unroll") for (int n = 0; n < 2; ++n) _Pragma("unroll") for (int k = 0; k < 2; ++k) \
        acc[ai][bj][m][n] = __builtin_amdgcn_mfma_f32_16x16x32_bf16(Bt[n][k], At[m][k], acc[ai][bj][m][n], 0, 0, 0); __builtin_amdgcn_s_setprio(0); } while (0)
#define PG8_WAIT_V(n) asm volatile("s_waitcnt vmcnt(" #n ")" ::: "memory")
#define PG8_WAIT_L(n) asm volatile("s_waitcnt lgkmcnt(" #n ")" ::: "memory")
#define PG8_BAR __builtin_amdgcn_s_barrier()
#define PG8_SCHED __builtin_amdgcn_sched_barrier(0)
#define PG8_AOFFS(dst, u) do { _Pragma("unroll") for (int _h = 0; _h < 2; ++_h) _Pragma("unroll") for (int _i = 0; _i < 2; ++_i) { \
        const int _r = (u).pm * BM + _h * HALF + Rr[_i]; const int _s = GATHER ? g.rows[_r] : _r; dst[_h][_i] = (unsigned)(_s * K + Cc[_i]) * 2u; } } while (0)
#define PG8_DEPWAIT(tile) do { if (wid == 0) { const unsigned* _w = g.dep + (tile); unsigned _sp = 0; \
            while ((unsigned)__builtin_amdgcn_readfirstlane((int)__hip_atomic_load(_w, __ATOMIC_RELAXED, __HIP_MEMORY_SCOPE_AGENT)) < 8u && ++_sp < (1u << 22)) __builtin_amdgcn_s_sleep(1); \
            __builtin_amdgcn_fence(__ATOMIC_ACQUIRE, "agent"); asm volatile("s_waitcnt vmcnt(0)" ::: "memory"); } \
        PG8_BAR; } while (0)
    Unit cur, nxt; int ui = 0;
    if (!S.next(0, cur)) return;
    if (DEP == 2) PG8_DEPWAIT(cur.pm);
    f32x4 acc[2][2][4][2];
#pragma unroll
    for (int a = 0; a < 2; ++a)
#pragma unroll
        for (int b = 0; b < 2; ++b)
#pragma unroll
            for (int m = 0; m < 4; ++m)
#pragma unroll
                for (int n = 0; n < 2; ++n) acc[a][b][m][n] = (f32x4){0.f, 0.f, 0.f, 0.f};
    bf16x8 At[4][2], B0[2][2], B1[2][2];
    const char* Ab = (const char*)g.A + cur.kofs;
    unsigned oA[2][2], nOA[2][2];
    PG8_AOFFS(oA, cur);
    const char* cB = (const char*)g.Bt + (size_t)cur.e * g.bstride + (size_t)cur.pn * tstep + cur.kofs;
    PG8_STAGE(PG8_SB(0, 0), cB, voffB); PG8_STAGE(PG8_SB(0, 1), cB + hstep, voffB); PG8_STAGE(PG8_SA(0, 0), Ab, oA[0]); PG8_STAGE(PG8_SA(0, 1), Ab, oA[1]);
    if (wr == 1) PG8_BAR;
    PG8_WAIT_V(2); PG8_BAR;
    PG8_STAGE(PG8_SB(1, 0), cB + kstep, voffB); PG8_STAGE(PG8_SA(1, 0), Ab + kstep, oA[0]); PG8_STAGE(PG8_SB(1, 1), cB + hstep + kstep, voffB);
    PG8_WAIT_V(6); PG8_BAR;
    for (;;) {
        const bool has_next = S.next(ui + 1, nxt);
        if (has_next) { PG8_AOFFS(nOA, nxt); }
        else {
#pragma unroll
            for (int h = 0; h < 2; ++h)
#pragma unroll
                for (int i = 0; i < 2; ++i) nOA[h][i] = oA[h][i];
        }
        const char* nB = has_next ? (const char*)g.Bt + (size_t)nxt.e * g.bstride + (size_t)nxt.pn * tstep + nxt.kofs : cB;
        const char* nAb = has_next ? (const char*)g.A + nxt.kofs : Ab;
        const int nt = cur.nt;
        for (int t = 0; t < nt; t += 2) {
            const bool last = (t == nt - 2);
            if (DEP == 2) { if (last && has_next) PG8_DEPWAIT(nxt.pm); }
            const char* a1 = Ab + (size_t)(t + 1) * kstep;
            const char* a2 = last ? nAb : Ab + (size_t)(t + 2) * kstep; const char* b2 = last ? nB : cB + (size_t)(t + 2) * kstep;
            const char* a3 = a2 + kstep; const char* b3 = b2 + kstep;
            unsigned s0[2], s1[2];
#pragma unroll
            for (int i = 0; i < 2; ++i) { s0[i] = last ? nOA[0][i] : oA[0][i]; s1[i] = last ? nOA[1][i] : oA[1][i]; }
            PG8_LDB(B0, 0, 0); PG8_LDB(B1, 0, 1); PG8_SCHED; PG8_LDA(At, 0, 0); PG8_STAGE(PG8_SA(1, 1), a1, oA[1]);
            PG8_WAIT_V(8); PG8_WAIT_L(0); PG8_BAR; PG8_MMA(0, 0, At, B0); PG8_MMA(0, 1, At, B1); PG8_BAR; PG8_SCHED;
            PG8_LDA(At, 0, 1); PG8_STAGE(PG8_SB(0, 0), b2, voffB); PG8_STAGE(PG8_SB(0, 1), b2 + hstep, voffB); PG8_STAGE(PG8_SA(0, 0), a2, s0);
            PG8_WAIT_V(8); PG8_WAIT_L(0); PG8_BAR; PG8_MMA(1, 0, At, B0); PG8_MMA(1, 1, At, B1); PG8_BAR; PG8_SCHED;
            PG8_LDB(B0, 1, 0); PG8_LDB(B1, 1, 1); PG8_SCHED; PG8_LDA(At, 1, 0); PG8_STAGE(PG8_SA(0, 1), a2, s1);
            PG8_WAIT_V(8); PG8_WAIT_L(0); PG8_BAR; PG8_MMA(0, 0, At, B0); PG8_MMA(0, 1, At, B1); PG8_BAR; PG8_SCHED;
            PG8_LDA(At, 1, 1); PG8_STAGE(PG8_SB(1, 0), b3, voffB); PG8_STAGE(PG8_SB(1, 1), b3 + hstep, voffB); PG8_STAGE(PG8_SA(1, 0), a3, s0);
            PG8_WAIT_V(8); PG8_WAIT_L(0); PG8_BAR; PG8_MMA(1, 0, At, B0); PG8_MMA(1, 1, At, B1); PG8_BAR; PG8_SCHED;
        }
        if (wr == 0) PG8_BAR;
        bool keep = false;
        if constexpr (Epi::MIDSCALE) { if (cur.e < 2) { E.mid(acc, cur, cur.e, wr, wc, fr, fq); keep = true; } else E(acc, cur, wr, wc, fr, fq); }
        else E(acc, cur, wr, wc, fr, fq);
        if (DEP == 1) { PG8_WAIT_V(0); PG8_BAR; if (tid == 0) __hip_atomic_fetch_add(g.dep + cur.pm, 1u, __ATOMIC_RELAXED, __HIP_MEMORY_SCOPE_AGENT); }
        if (!has_next) break;
        if (!keep) {
#pragma unroll
        for (int a = 0; a < 2; ++a)
#pragma unroll
            for (int b = 0; b < 2; ++b)
#pragma unroll
                for (int m = 0; m < 4; ++m)
#pragma unroll
                    for (int n = 0; n < 2; ++n) acc[a][b][m][n] = (f32x4){0.f, 0.f, 0.f, 0.f};
        }
        cur = nxt; cB = nB; Ab = nAb; ++ui;
#pragma unroll
        for (int h = 0; h < 2; ++h)
#pragma unroll
            for (int i = 0; i < 2; ++i) oA[h][i] = nOA[h][i];
        if (wr == 1) PG8_BAR;
    }
    PG8_WAIT_V(0);
    PG8_BAR;
#undef PG8_SA
#undef PG8_SB
#undef PG8_STAGE
#undef PG8_LDA
#undef PG8_LDB
#undef PG8_MMA
#undef PG8_WAIT_V
#undef PG8_WAIT_L
#undef PG8_BAR
#undef PG8_SCHED
#undef PG8_AOFFS
#undef PG8_DEPWAIT
}

struct EpiInProj {
    static constexpr bool PERM = true; static constexpr bool MIDSCALE = false;
    bf16_t* act; float* small;
    __device__ __forceinline__ void operator()(const f32x4 (&acc)[2][2][4][2], const Unit& u, int wr, int wc, int fr, int fq) const {
        const int row0 = u.pm * BM + wr * 64 + fr;
        if (u.pn == 46) {
            if (wc == 0) {
#pragma unroll
                for (int ai = 0; ai < 2; ++ai)
#pragma unroll
                    for (int m = 0; m < 4; ++m) { float* p = small + (size_t)(row0 + ai * HALF + m * 16) * 32 + 8 * fq; *(f32x4*)p = acc[ai][0][m][0]; *(f32x4*)(p + 4) = acc[ai][0][m][1]; }
            }
            return;
        }
        const int mode = (u.pn < 2) ? 1 : (u.pn >= 22 ? 2 : 0);
        const int col0 = u.pn * BM + wc * 32 + 8 * fq;
#pragma unroll
        for (int ai = 0; ai < 2; ++ai)
#pragma unroll
            for (int m = 0; m < 4; ++m) { bf16_t* rowp = act + (size_t)(row0 + ai * HALF + m * 16) * NPAD + col0;
#pragma unroll
                for (int bj = 0; bj < 2; ++bj) { f32x4 v0 = acc[ai][bj][m][0], v1 = acc[ai][bj][m][1];
                    if (mode == 1) { v0 = v0 * CQK; v1 = v1 * CQK; }
                    if (mode == 2) {
#pragma unroll
                        for (int j = 0; j < 4; ++j) { v0[j] = sigmoid_f(v0[j]); v1[j] = sigmoid_f(v1[j]); } }
                    u32x4 w; w.x = cvt_pk_bf16(v0[0], v0[1]); w.y = cvt_pk_bf16(v0[2], v0[3]); w.z = cvt_pk_bf16(v1[0], v1[1]); w.w = cvt_pk_bf16(v1[2], v1[3]);
                    if (mode == 2) __builtin_nontemporal_store(w, (u32x4*)(rowp + bj * HALF)); else *(u32x4*)(rowp + bj * HALF) = w; } }
    }
};

struct Frame { FX_LAS unsigned char* lds; int tid, lane, wave, G, gw, NGW; };

__device__ __forceinline__ void transpose_item(const float* W, int ldw, int scol, int k0, bf16_t* WT, int Kd, int drow, FX_LAS float* scr, int lane) {
    f32x2 v[32];
#pragma unroll
    for (int i = 0; i < 32; ++i) { const int kk = 2 * i + (lane >> 5); v[i] = *(const f32x2*)(W + (size_t)(k0 + kk) * ldw + scol + 2 * (lane & 31)); }
#pragma unroll
    for (int i = 0; i < 32; ++i) { const int kk = 2 * i + (lane >> 5); scr[kk * 65 + 2 * (lane & 31)] = v[i][0]; scr[kk * 65 + 2 * (lane & 31) + 1] = v[i][1]; }
    asm volatile("s_waitcnt lgkmcnt(0)" ::: "memory");
    const int c = lane & 7;
#pragma unroll
    for (int j = 0; j < 8; ++j) { const int n = (lane >> 3) + 8 * j; const FX_LAS float* s = scr + (8 * c) * 65 + n;
        u32x4 o; o.x = cvt_pk_bf16(s[0 * 65], s[1 * 65]); o.y = cvt_pk_bf16(s[2 * 65], s[3 * 65]); o.z = cvt_pk_bf16(s[4 * 65], s[5 * 65]); o.w = cvt_pk_bf16(s[6 * 65], s[7 * 65]);
        *(u32x4*)(WT + (size_t)(drow + n) * Kd + k0 + 8 * c) = o; }
    asm volatile("s_waitcnt lgkmcnt(0)" ::: "memory");
}

constexpr int I_IN = 184 * 32, I_SB = 32 * 8, I_FOX = 32 * 8, I_SSM = 32 * 16, I_OUT = 32 * 32, I_G = 16 * 16 * 32, I_U = I_G, I_D = 16 * 32 * 16;
constexpr int I_LAYER = I_IN + I_SB + I_FOX + I_SSM + I_OUT + I_G + I_U + I_D;
__device__ __forceinline__ void convert_in1(const FX_CAS Args* a, const Frame& F) {
    FX_LAS float* scr = (FX_LAS float*)(F.lds + F.wave * 16896);
    for (int r0 = F.gw; r0 < I_IN; r0 += F.NGW) { const int r = I_IN - 1 - r0; const int nb = r / 32, kb = r % 32, dcol = nb * 64, scol = dcol + (dcol < 3072 ? 0 : (dcol < 5632 ? 4 : 20));
        transpose_item(a->in[5] + (size_t)D * NP, NP, scol, kb * 64, a->w_in_t + (size_t)NPAD * D, D, dcol, scr, F.lane); }
}
__device__ __forceinline__ void convert_brout(const FX_CAS Args* a, const Frame& F, int l, int wf, int nf) {
    FX_LAS float* scr = (FX_LAS float*)(F.lds + F.wave * 16896);
    bf16_t* br = a->w_br_t + (size_t)l * D * D;
    for (int r0 = wf; r0 < I_SB + I_FOX + I_SSM + I_OUT; r0 += nf) { int r = r0;
        if (r < I_SB) { const int nb = r / 8, kb = r % 8; transpose_item(a->in[15] + (size_t)l * 512 * D, D, nb * 64, kb * 64, br, D, nb * 64, scr, F.lane); continue; } r -= I_SB;
        if (r < I_FOX) { const int nb = r / 8, kb = r % 8; transpose_item(a->in[16] + (size_t)l * 512 * D, D, nb * 64, kb * 64, br + 512, D, nb * 64, scr, F.lane); continue; } r -= I_FOX;
        if (r < I_SSM) { const int nb = r / 16, kb = r % 16; transpose_item(a->in[17] + (size_t)l * 1024 * D, D, nb * 64, kb * 64, br + 1024, D, nb * 64, scr, F.lane); continue; } r -= I_SSM;
        { const int nb = r / 32, kb = r % 32; transpose_item(a->in[18] + (size_t)l * D * D, D, nb * 64, kb * 64, a->w_out_t + (size_t)l * D * D, D, nb * 64, scr, F.lane); }
    }
}
__device__ __forceinline__ void moe_item(const FX_CAS Args* a, int l, int m, FX_LAS float* scr, int lane) {
    int r = m;
    if (r < I_G + I_U) { const int up = r >= I_G; if (up) r -= I_G; const int e = r / 512, q = r % 512, nb = q / 32, kb = q % 32;
        const float* src = (up ? a->in[23] : a->in[22]) + ((size_t)l * NE + e) * D * FF;
        bf16_t* dst = a->w_gu_t + ((size_t)l * NE + e) * (size_t)D * D;
        transpose_item(src, FF, nb * 64, kb * 64, dst, D, 256 * (nb >> 1) + 64 * (nb & 1) + (up ? 128 : 0), scr, lane); return; }
    r -= I_G + I_U;
    { const int e = r / 512, q = r % 512, nb = q / 16, kb = q % 16;
        transpose_item(a->in[24] + ((size_t)l * NE + e) * FF * D, D, nb * 64, kb * 64, a->w_d_t + ((size_t)l * NE + e) * (size_t)D * FF, FF, nb * 64, scr, lane); }
}
constexpr int MOE_NA = 2048, MOE_NB = 3072;
__device__ __forceinline__ void convert_moe(const FX_CAS Args* a, const Frame& F, int l, int first, int count, int wf, int nf) {
    FX_LAS float* scr = (FX_LAS float*)(F.lds + F.wave * 16896);
    for (int m = wf; m < count; m += nf) moe_item(a, l, first + m, scr, F.lane);
}
__device__ __forceinline__ void phase_prologue(const FX_CAS Args* a, const Frame& F) {
    FX_LAS float* scr = (FX_LAS float*)(F.lds + F.wave * 16896);
    {
        FX_LAS float* sc = (FX_LAS float*)(F.lds + 131072);
        for (int i = F.tid; i < D; i += NTHR) sc[i] = silu_f(a->in[1][i]);
        __syncthreads();
        for (int it = F.gw; it < 2 * 384; it += F.NGW) {
            const int l = it / 384, j0 = (it % 384) * 32, rg = F.lane >> 3, cg = F.lane & 7;
            const float* w = a->in[2] + (size_t)l * D * 6 * D + (size_t)rg * 6 * D + j0 + 4 * cg;
            f32x4 acc = (f32x4){0.f, 0.f, 0.f, 0.f};
            for (int i = 0; i < 256; i += 16) {
                f32x4 wv[16];
#pragma unroll
                for (int k = 0; k < 16; ++k) wv[k] = *(const f32x4*)(w + (size_t)(i + k) * 8 * 6 * D);
#pragma unroll
                for (int k = 0; k < 16; ++k) acc += wv[k] * sc[rg + 8 * (i + k)];
            }
#pragma unroll
            for (int k = 0; k < 4; ++k) { float v = acc[k]; const int ln = fx_lane(); v += shfl_xorl(v, 8, ln); v += shfl_xorl(v, 16, ln); v += shfl_xorl(v, 32, ln); acc[k] = v; }
            if (rg == 0) { const f32x4 bv = *(const f32x4*)(a->in[3] + l * 6 * D + j0 + 4 * cg); *(f32x4*)(a->mod + l * 6 * D + j0 + 4 * cg) = acc + bv; }
        }
    }
    __syncthreads();
    constexpr int I_BO = I_SB + I_FOX + I_SSM + I_OUT, I_MOE = I_G + I_U + I_D;
    const int nab = (gridDim.x == 256) ? MOE_NA + MOE_NB : 0;
    const int mrem = I_MOE - nab, ipro = I_IN + 2 * mrem;
    for (int j0 = F.gw; j0 < ipro; j0 += F.NGW) {
        const int j = ipro - 1 - j0;
        if (j < I_IN) { const int r = j; const int nb = r / 32, kb = r % 32, dcol = nb * 64, scol = dcol + (dcol < 3072 ? 0 : (dcol < 5632 ? 4 : 20));
            transpose_item(a->in[5], NP, scol, kb * 64, a->w_in_t, D, dcol, scr, F.lane); continue; }
        const int jj = j - I_IN; const int l = jj / mrem;
        moe_item(a, l, nab + jj % mrem, scr, F.lane);
    }
    for (int idx = F.gw * 64 + F.lane; idx < 2 * 256 * 256; idx += F.NGW * 64) {
        const int l = idx >> 16, rr = (idx >> 8) & 255, ch = idx & 255;
        u32x4 o = (u32x4){0u, 0u, 0u, 0u};
        if (rr < 20) { const int scol = rr < 4 ? 3072 + rr : 5636 + (rr - 4); const float* w = a->in[5] + (size_t)l * D * NP + (size_t)(ch * 8) * NP + scol;
            o.x = cvt_pk_bf16(w[0], w[NP]); o.y = cvt_pk_bf16(w[2 * (size_t)NP], w[3 * (size_t)NP]); o.z = cvt_pk_bf16(w[4 * (size_t)NP], w[5 * (size_t)NP]); o.w = cvt_pk_bf16(w[6 * (size_t)NP], w[7 * (size_t)NP]); }
        *(u32x4*)(a->w_in_t + (size_t)l * NPAD * D + (size_t)(C_SMALL + rr) * D + ch * 8) = o;
    }
}

template <bool COMBINE, bool NORM, bool XIN_BF = false, bool XOUT_BF = false>
__device__ __forceinline__ void phase_normmod(const Frame& F, const void* xin, void* xout, const float* gprev, const bf16_t* ybuf, const int* slot, const float* wsel, const bf16_t* delta,
                                               const float* gain, const float* scale, const float* shift, bf16_t* hb) {
    for (int m = F.gw; m < S; m += F.NGW) {
        f32x4 v[8];
        if (XIN_BF) { const u32x2* xr = (const u32x2*)((const bf16_t*)xin + (size_t)m * D) + F.lane;
#pragma unroll
            for (int j = 0; j < 8; ++j) { const u32x2 xv = xr[64 * j]; v[j] = (f32x4){bflo(xv.x), bfhi(xv.x), bflo(xv.y), bfhi(xv.y)}; } }
        else { const f32x4* xr = (const f32x4*)((const float*)xin + (size_t)m * D) + F.lane;
#pragma unroll
            for (int j = 0; j < 8; ++j) v[j] = xr[64 * j]; }
        if (COMBINE) {
            const int s0 = slot[m * 2], s1 = slot[m * 2 + 1]; const float w0 = wsel[m * 2], w1 = wsel[m * 2 + 1];
            const u32x2* y0 = (const u32x2*)(ybuf + (size_t)s0 * D) + F.lane; const u32x2* y1 = (const u32x2*)(ybuf + (size_t)s1 * D) + F.lane;
            const u32x2* dl = (const u32x2*)(delta + (size_t)m * D) + F.lane;
#pragma unroll
            for (int j = 0; j < 8; ++j) { const u32x2 dv = dl[64 * j]; v[j][0] += bflo(dv.x); v[j][1] += bfhi(dv.x); v[j][2] += bflo(dv.y); v[j][3] += bfhi(dv.y); }
#pragma unroll
            for (int j = 0; j < 8; ++j) { const u32x2 a0 = y0[64 * j], a1 = y1[64 * j]; const f32x4 gp = ((const f32x4*)gprev)[F.lane + 64 * j];
                v[j][0] += gp[0] * (w0 * bflo(a0.x) + w1 * bflo(a1.x)); v[j][1] += gp[1] * (w0 * bfhi(a0.x) + w1 * bfhi(a1.x));
                v[j][2] += gp[2] * (w0 * bflo(a0.y) + w1 * bflo(a1.y)); v[j][3] += gp[3] * (w0 * bfhi(a0.y) + w1 * bfhi(a1.y)); }
            if (XOUT_BF) { u32x2* xo = (u32x2*)((bf16_t*)xout + (size_t)m * D) + F.lane;
#pragma unroll
                for (int j = 0; j < 8; ++j) { u32x2 w; w.x = cvt_pk_bf16(v[j][0], v[j][1]); w.y = cvt_pk_bf16(v[j][2], v[j][3]); xo[64 * j] = w;
                    v[j] = (f32x4){bflo(w.x), bfhi(w.x), bflo(w.y), bfhi(w.y)}; } }
            else { f32x4* xo = (f32x4*)((float*)xout + (size_t)m * D) + F.lane;
#pragma unroll
                for (int j = 0; j < 8; ++j) xo[64 * j] = v[j]; }
        }
        if (NORM) {
            float ss = 0.f;
#pragma unroll
            for (int j = 0; j < 8; ++j) ss += (v[j][0] * v[j][0] + v[j][1] * v[j][1]) + (v[j][2] * v[j][2] + v[j][3] * v[j][3]);
            const float rs = rsqrtf(wave_sum(ss) * (1.0f / D) + 1e-6f);
            u32x2* o = (u32x2*)(hb + (size_t)m * D) + F.lane;
#pragma unroll
            for (int j = 0; j < 8; ++j) { const f32x4 gg = ((const f32x4*)gain)[F.lane + 64 * j], sc = ((const f32x4*)scale)[F.lane + 64 * j], sh = ((const f32x4*)shift)[F.lane + 64 * j];
                f32x4 h;
#pragma unroll
                for (int k = 0; k < 4; ++k) h[k] = v[j][k] * rs * gg[k] * (1.0f + sc[k]) + sh[k];
                u32x2 w; w.x = cvt_pk_bf16(h[0], h[1]); w.y = cvt_pk_bf16(h[2], h[3]); o[64 * j] = w; }
        }
    }
}

template <bool FIRST> struct EpiBranch {
    static constexpr bool PERM = true; static constexpr bool MIDSCALE = false;
    const bf16_t* gates; bf16_t* merged;
    __device__ __forceinline__ void operator()(const f32x4 (&acc)[2][2][4][2], const Unit& u, int wr, int wc, int fr, int fq) const {
        const int row0 = u.pm * BM + wr * 64 + fr, col0 = u.pn * BM + wc * 32 + 8 * fq;
#pragma unroll
        for (int ai = 0; ai < 2; ++ai)
#pragma unroll
            for (int m = 0; m < 4; ++m) { const size_t row = (size_t)(row0 + ai * HALF + m * 16);
#pragma unroll
                for (int bj = 0; bj < 2; ++bj) { const int col = col0 + bj * HALF;
                    const u32x4 gw = *(const u32x4*)(gates + row * NPAD + col);
                    u32x4 pw = (u32x4){0u, 0u, 0u, 0u}; if (!FIRST) pw = *(const u32x4*)(merged + row * D + col);
                    const f32x4 v0 = acc[ai][bj][m][0], v1 = acc[ai][bj][m][1];
                    float o[8];
                    o[0] = bflo(pw.x) + bflo(gw.x) * v0[0]; o[1] = bfhi(pw.x) + bfhi(gw.x) * v0[1]; o[2] = bflo(pw.y) + bflo(gw.y) * v0[2]; o[3] = bfhi(pw.y) + bfhi(gw.y) * v0[3];
                    o[4] = bflo(pw.z) + bflo(gw.z) * v1[0]; o[5] = bfhi(pw.z) + bfhi(gw.z) * v1[1]; o[6] = bflo(pw.w) + bflo(gw.w) * v1[2]; o[7] = bfhi(pw.w) + bfhi(gw.w) * v1[3];
                    u32x4 w; w.x = cvt_pk_bf16(o[0], o[1]); w.y = cvt_pk_bf16(o[2], o[3]); w.z = cvt_pk_bf16(o[4], o[5]); w.w = cvt_pk_bf16(o[6], o[7]);
                    *(u32x4*)(merged + row * D + col) = w; } }
    }
};
struct EpiOut {
    static constexpr bool PERM = true; static constexpr bool MIDSCALE = false;
    bf16_t* delta; const float* gm;
    __device__ __forceinline__ void operator()(const f32x4 (&acc)[2][2][4][2], const Unit& u, int wr, int wc, int fr, int fq) const {
        const int row0 = u.pm * BM + wr * 64 + fr, col0 = u.pn * BM + wc * 32 + 8 * fq;
        f32x4 gv[2][2];
#pragma unroll
        for (int bj = 0; bj < 2; ++bj)
#pragma unroll
            for (int n = 0; n < 2; ++n) gv[bj][n] = *(const f32x4*)(gm + col0 + bj * HALF + n * 4);
#pragma unroll
        for (int ai = 0; ai < 2; ++ai)
#pragma unroll
            for (int m = 0; m < 4; ++m) { bf16_t* rowp = delta + (size_t)(row0 + ai * HALF + m * 16) * D + col0;
#pragma unroll
                for (int bj = 0; bj < 2; ++bj) { const f32x4 v0 = acc[ai][bj][m][0] * gv[bj][0], v1 = acc[ai][bj][m][1] * gv[bj][1];
                    u32x4 w; w.x = cvt_pk_bf16(v0[0], v0[1]); w.y = cvt_pk_bf16(v0[2], v0[3]); w.z = cvt_pk_bf16(v1[0], v1[1]); w.w = cvt_pk_bf16(v1[2], v1[3]);
                    *(u32x4*)(rowp + bj * HALF) = w; } }
    }
};
struct EpiGateUp {
    static constexpr bool PERM = true; static constexpr bool MIDSCALE = false;
    bf16_t* actb;
    __device__ __forceinline__ void operator()(const f32x4 (&acc)[2][2][4][2], const Unit& u, int wr, int wc, int fr, int fq) const {
        const int row0 = u.pm * BM + wr * 64 + fr, col0 = u.pn * HALF + wc * 32 + 8 * fq;
        const __amdgpu_buffer_rsrc_t rsrc = __builtin_amdgcn_make_buffer_rsrc(actb, 0, SLOTCAP * FF * 2, 0x00020000);
#pragma unroll
        for (int ai = 0; ai < 2; ++ai)
#pragma unroll
            for (int m = 0; m < 4; ++m) { const size_t row = (size_t)(row0 + ai * HALF + m * 16);
                float o[8];
#pragma unroll
                for (int n = 0; n < 2; ++n)
#pragma unroll
                    for (int j = 0; j < 4; ++j) o[n * 4 + j] = silu_f(acc[ai][0][m][n][j]) * acc[ai][1][m][n][j];
                u32x4 w; w.x = cvt_pk_bf16(o[0], o[1]); w.y = cvt_pk_bf16(o[2], o[3]); w.z = cvt_pk_bf16(o[4], o[5]); w.w = cvt_pk_bf16(o[6], o[7]);
                __builtin_amdgcn_raw_buffer_store_b128(w, rsrc, (unsigned)((row * FF + col0) * 2), 0, 16); }
    }
};
struct EpiDown {
    static constexpr bool PERM = true; static constexpr bool MIDSCALE = false;
    bf16_t* ybuf;
    __device__ __forceinline__ void operator()(const f32x4 (&acc)[2][2][4][2], const Unit& u, int wr, int wc, int fr, int fq) const {
        const int row0 = u.pm * BM + wr * 64 + fr, col0 = u.pn * BM + wc * 32 + 8 * fq;
#pragma unroll
        for (int ai = 0; ai < 2; ++ai)
#pragma unroll
            for (int m = 0; m < 4; ++m) { bf16_t* rowp = ybuf + (size_t)(row0 + ai * HALF + m * 16) * D + col0;
#pragma unroll
                for (int bj = 0; bj < 2; ++bj) { const f32x4 v0 = acc[ai][bj][m][0], v1 = acc[ai][bj][m][1];
                    u32x4 w; w.x = cvt_pk_bf16(v0[0], v0[1]); w.y = cvt_pk_bf16(v0[2], v0[3]); w.z = cvt_pk_bf16(v1[0], v1[1]); w.w = cvt_pk_bf16(v1[2], v1[3]);
                    *(u32x4*)(rowp + bj * HALF) = w; } }
    }
};

struct EpiBranchRT {
    static constexpr bool PERM = true; static constexpr bool MIDSCALE = false;
    const bf16_t* gates; bf16_t* merged;
    __device__ __forceinline__ void operator()(const f32x4 (&acc)[2][2][4][2], const Unit& u, int wr, int wc, int fr, int fq) const {
        const int row0 = u.pm * BM + wr * 64 + fr, col0 = u.pn * BM + wc * 32 + 8 * fq;
        const bool first = (u.e == 0);
        const bf16_t* gb = gates + (size_t)u.e * D;
#pragma unroll
        for (int ai = 0; ai < 2; ++ai)
#pragma unroll
            for (int m = 0; m < 4; ++m) { const size_t row = (size_t)(row0 + ai * HALF + m * 16);
#pragma unroll
                for (int bj = 0; bj < 2; ++bj) { const int col = col0 + bj * HALF;
                    const u32x4 gw = *(const u32x4*)(gb + row * NPAD + col);
                    u32x4 pw = (u32x4){0u, 0u, 0u, 0u}; if (!first) pw = *(const u32x4*)(merged + row * D + col);
                    const f32x4 v0 = acc[ai][bj][m][0], v1 = acc[ai][bj][m][1];
                    float o[8];
                    o[0] = bflo(pw.x) + bflo(gw.x) * v0[0]; o[1] = bfhi(pw.x) + bfhi(gw.x) * v0[1]; o[2] = bflo(pw.y) + bflo(gw.y) * v0[2]; o[3] = bfhi(pw.y) + bfhi(gw.y) * v0[3];
                    o[4] = bflo(pw.z) + bflo(gw.z) * v1[0]; o[5] = bfhi(pw.z) + bfhi(gw.z) * v1[1]; o[6] = bflo(pw.w) + bflo(gw.w) * v1[2]; o[7] = bfhi(pw.w) + bfhi(gw.w) * v1[3];
                    u32x4 w; w.x = cvt_pk_bf16(o[0], o[1]); w.y = cvt_pk_bf16(o[2], o[3]); w.z = cvt_pk_bf16(o[4], o[5]); w.w = cvt_pk_bf16(o[6], o[7]);
                    *(u32x4*)(merged + row * D + col) = w; } }
    }
};
struct EpiBranchFused {
    static constexpr bool PERM = true; static constexpr bool MIDSCALE = true;
    const bf16_t* gates; bf16_t* merged;
    __device__ __forceinline__ void mid(f32x4 (&acc)[2][2][4][2], const Unit& u, int e, int wr, int wc, int fr, int fq) const {
        const char* ga = (const char*)(gates + (size_t)e * D);
        const unsigned off0 = (unsigned)((u.pm * BM + wr * 64 + fr) * NPAD + u.pn * BM + wc * 32 + 8 * fq) * 2u;
#pragma unroll
        for (int ai = 0; ai < 2; ++ai) {
#pragma unroll
            for (int m = 0; m < 4; ++m) {
#pragma unroll
                for (int bj = 0; bj < 2; ++bj) { const unsigned off = off0 + (unsigned)(((ai * HALF + m * 16) * NPAD + bj * HALF) * 2);
                    const u32x4 pa = *(const u32x4*)(ga + off), pb = *(const u32x4*)(ga + D * 2 + off);
                    float r[8];
                    r[0] = bflo(pa.x) * fast_rcp(fmaxf(bflo(pb.x), 1e-20f)); r[1] = bfhi(pa.x) * fast_rcp(fmaxf(bfhi(pb.x), 1e-20f));
                    r[2] = bflo(pa.y) * fast_rcp(fmaxf(bflo(pb.y), 1e-20f)); r[3] = bfhi(pa.y) * fast_rcp(fmaxf(bfhi(pb.y), 1e-20f));
                    r[4] = bflo(pa.z) * fast_rcp(fmaxf(bflo(pb.z), 1e-20f)); r[5] = bfhi(pa.z) * fast_rcp(fmaxf(bfhi(pb.z), 1e-20f));
                    r[6] = bflo(pa.w) * fast_rcp(fmaxf(bflo(pb.w), 1e-20f)); r[7] = bfhi(pa.w) * fast_rcp(fmaxf(bfhi(pb.w), 1e-20f));
#pragma unroll
                    for (int j = 0; j < 4; ++j) { acc[ai][bj][m][0][j] *= r[j]; acc[ai][bj][m][1][j] *= r[4 + j]; } } }
            __builtin_amdgcn_sched_barrier(0);
        }
    }
    __device__ __forceinline__ void operator()(const f32x4 (&acc)[2][2][4][2], const Unit& u, int wr, int wc, int fr, int fq) const {
        const int row0 = u.pm * BM + wr * 64 + fr, col0 = u.pn * BM + wc * 32 + 8 * fq;
        const bf16_t* gb = gates + (size_t)2 * D;
#pragma unroll
        for (int ai = 0; ai < 2; ++ai)
#pragma unroll
            for (int m = 0; m < 4; ++m) { const size_t row = (size_t)(row0 + ai * HALF + m * 16);
#pragma unroll
                for (int bj = 0; bj < 2; ++bj) { const int col = col0 + bj * HALF;
                    const u32x4 gw = *(const u32x4*)(gb + row * NPAD + col);
                    const f32x4 v0 = acc[ai][bj][m][0], v1 = acc[ai][bj][m][1];
                    u32x4 w; w.x = cvt_pk_bf16(bflo(gw.x) * v0[0], bfhi(gw.x) * v0[1]); w.y = cvt_pk_bf16(bflo(gw.y) * v0[2], bfhi(gw.y) * v0[3]);
                    w.z = cvt_pk_bf16(bflo(gw.z) * v1[0], bfhi(gw.z) * v1[1]); w.w = cvt_pk_bf16(bflo(gw.w) * v1[2], bfhi(gw.w) * v1[3]);
                    *(u32x4*)(merged + row * D + col) = w; } }
    }
};
struct BranchOrder {
    StaticOrder so;
    __device__ bool next(int i, Unit& u) const {
        if (i >= 3) return false;
        if (!so.next(0, u)) return false;
        u.e = i; u.kofs = (i == 0) ? 0 : ((i == 1) ? 1024 : 2048); u.nt = (i == 2) ? 16 : 8; return true;
    }
};
__device__ __forceinline__ void phase_branch(const FX_CAS Args* a, const Frame& F, int l) {
    Gemm g{a->osb, a->w_br_t + (size_t)l * D * D, D, 0, nullptr};
    BranchOrder Bo; Bo.so.init(S, D, D, F.G, (int)blockIdx.x);
    EpiBranchFused E{a->act + C_GATE, a->merged};
    gemm_phase<EpiBranchFused, BranchOrder, false>(F.lds, F.tid, g, Bo, E);
}
__device__ __forceinline__ void phase_out(const FX_CAS Args* a, const Frame& F, int l) {
    Gemm g{a->merged, a->w_out_t + (size_t)l * D * D, D, 0, nullptr}; StaticOrder So; So.init(S, D, D, F.G, (int)blockIdx.x);
    EpiOut E{a->osb, a->mod + (size_t)l * 6 * D + 2 * D};
    gemm_phase<EpiOut, StaticOrder, false>(F.lds, F.tid, g, So, E);
}

__device__ __forceinline__ unsigned offV(unsigned row, unsigned ch) { return 256u * row + 16u * (ch ^ (((row & 3u) << 2) | ((row >> 2) & 3u))); }
__device__ __forceinline__ unsigned offK(unsigned row, unsigned ch) { return 256u * row + 16u * (ch ^ ((((row >> 3) & 3u) << 2) | (row & 3u))); }
__device__ __forceinline__ unsigned trV16(unsigned lane, unsigned c, unsigned ks, unsigned t) {
    const unsigned g = lane >> 4, q = (lane & 15u) >> 2, p = lane & 3u;
    return offV(32u * ks + 8u * g + 4u * t + q, 2u * c + (p >> 1)) + 8u * (p & 1u);
}
__device__ __forceinline__ unsigned offVa(unsigned row, unsigned ch) { return 2048u * (row >> 3) + 512u * (ch >> 2) + 64u * (row & 7u) + 16u * ((ch & 3u) ^ ((row >> 2) & 3u)); }
__device__ __forceinline__ unsigned trVa16(unsigned lane, unsigned c, unsigned ks, unsigned t) {
    const unsigned g = lane >> 4, q = (lane & 15u) >> 2, p = lane & 3u;
    return offVa(32u * ks + 8u * g + 4u * t + q, 2u * c + (p >> 1)) + 8u * (p & 1u);
}
#define ATT_BAR() do { __builtin_amdgcn_sched_barrier(0); asm volatile("s_waitcnt lgkmcnt(0)" ::: "memory"); __syncthreads(); __builtin_amdgcn_sched_barrier(0); } while (0)
#ifndef ATT_NOSTAG
#define ATT_NOSTAG 0
#endif
constexpr int ATT_KS = 0, ATT_VS = 32768, ATT_FTAB = 65536;

template <int KOFF>
__device__ __forceinline__ void att_qk(FX_LAS unsigned char* lds, const unsigned (&kbase)[4], const bf16x8 (&qf)[4], f32x4 (&st)[2][2]) {
    bf16x8 kf[2][2][4];
#pragma unroll
    for (int ks = 0; ks < 2; ++ks)
#pragma unroll
        for (int t = 0; t < 2; ++t)
#pragma unroll
            for (int kk = 0; kk < 4; ++kk) kf[ks][t][kk] = *(const FX_LAS bf16x8*)(lds + kbase[kk] + (KOFF + 8192 * ks + 1024 * t));
#pragma unroll
    for (int ks = 0; ks < 2; ++ks)
#pragma unroll
        for (int t = 0; t < 2; ++t) { f32x4 acc = (f32x4){0.f, 0.f, 0.f, 0.f};
#pragma unroll
            for (int kk = 0; kk < 4; ++kk) acc = __builtin_amdgcn_mfma_f32_16x16x32_bf16(kf[ks][t][kk], qf[kk], acc, 0, 0, 0);
            st[ks][t] = acc; }
}
template <int VOFF>
__device__ __forceinline__ void att_pv(FX_LAS unsigned char* lds, const unsigned (&vbase)[8][2], const bf16x8 (&pf)[2], f32x4 (&ot)[8]) {
#pragma unroll
    for (int hc = 0; hc < 2; ++hc) {
        s16x4 vr[4][2][2];
#pragma unroll
        for (int c = 0; c < 4; ++c)
#pragma unroll
            for (int ks = 0; ks < 2; ++ks)
#pragma unroll
                for (int t = 0; t < 2; ++t) vr[c][ks][t] = __builtin_amdgcn_ds_read_tr16_b64_v4i16((FX_LAS s16x4*)(lds + vbase[4 * hc + c][t] + (VOFF + 8192 * ks)));
#pragma unroll
        for (int c = 0; c < 4; ++c)
#pragma unroll
            for (int ks = 0; ks < 2; ++ks) { const bf16x8 vf = __builtin_shufflevector(vr[c][ks][0], vr[c][ks][1], 0, 1, 2, 3, 4, 5, 6, 7);
                ot[4 * hc + c] = __builtin_amdgcn_mfma_f32_16x16x32_bf16(vf, pf[ks], ot[4 * hc + c], 0, 0, 0); }
    }
}
template <bool FOX, bool MASK>
__device__ __forceinline__ void att_weights(const f32x4 (&st)[2][2], int j, int qrow, int g, int q, const FX_LAS float* ftab, float a_t, float& carry, float& den, bf16x8 (&pf)[2]) {
    const int keyb = 64 * j + 8 * g;
    float wgt[2][8];
    if (FOX) {
#pragma unroll
        for (int ks = 0; ks < 2; ++ks) {
            const f32x4 b0 = *(const FX_LAS f32x4*)(ftab + keyb + 32 * ks), b1 = *(const FX_LAS f32x4*)(ftab + keyb + 32 * ks + 4);
#pragma unroll
            for (int jj = 0; jj < 8; ++jj) { const float z = st[ks][jj >> 2][jj & 3], b = (jj < 4) ? b0[jj & 3] : b1[jj & 3];
                float p = fast_exp2(z + (a_t - b));
                if (MASK) p = ((keyb + 32 * ks + jj) <= qrow) ? p : 0.f;
                den += p; wgt[ks][jj] = p; }
        }
    } else {
        float tot1 = 1.0f;
#pragma unroll
        for (int ksi = 0; ksi < 2; ++ksi) { const int ks = 1 - ksi;
            float u[8], sfx[8];
#pragma unroll
            for (int jj = 0; jj < 8; ++jj) { const float z = __builtin_amdgcn_fmed3f(st[ks][jj >> 2][jj & 3], -1e30f, 60.f);
                float uu = fast_exp2(z), rr = fast_rcp(1.0f + uu);
                if (MASK) { const bool ok = (keyb + 32 * ks + jj) < qrow; uu = ok ? uu : 0.f; rr = ok ? rr : 1.f; }
                u[jj] = uu; sfx[jj] = rr; }
#pragma unroll
            for (int jj = 6; jj >= 0; --jj) sfx[jj] *= sfx[jj + 1];
            const float gp = sfx[0];
            const float g0 = shfl_idx(gp, q), g1 = shfl_idx(gp, 16 + q), g2 = shfl_idx(gp, 32 + q), g3 = shfl_idx(gp, 48 + q);
            const float t23 = g2 * g3;
            const float facq = (g == 0) ? g1 * t23 : ((g == 1) ? t23 : ((g == 2) ? g3 : 1.0f));
            const float tot = (g0 * g1) * t23;
            const float f = facq * tot1 * carry;
            if (ks == 1) tot1 = tot; else carry *= tot * tot1;
            u32x4 pw; pw.x = cvt_pk_bf16(u[0] * sfx[0] * f, u[1] * sfx[1] * f); pw.y = cvt_pk_bf16(u[2] * sfx[2] * f, u[3] * sfx[3] * f);
            pw.z = cvt_pk_bf16(u[4] * sfx[4] * f, u[5] * sfx[5] * f); pw.w = cvt_pk_bf16(u[6] * sfx[6] * f, u[7] * sfx[7] * f);
            pf[ks] = __builtin_bit_cast(bf16x8, pw);
            __builtin_amdgcn_sched_barrier(0);
        }
        return;
    }
#pragma unroll
    for (int ks = 0; ks < 2; ++ks) { u32x4 pw; pw.x = cvt_pk_bf16(wgt[ks][0], wgt[ks][1]); pw.y = cvt_pk_bf16(wgt[ks][2], wgt[ks][3]); pw.z = cvt_pk_bf16(wgt[ks][4], wgt[ks][5]); pw.w = cvt_pk_bf16(wgt[ks][6], wgt[ks][7]);
        pf[ks] = __builtin_bit_cast(bf16x8, pw); }
}

template <bool FOX>
__device__ __forceinline__ void attn_item(const Frame& F, const bf16_t* act, int qcol, int kcol, int vcol, int h, int qb, bf16_t* outp) {
    int lane_ = F.lane; asm volatile("" : "+v"(lane_));
    const int lane = lane_, w = F.wave, q = lane & 15, g = lane >> 4;
    const int qrow = qb * 128 + 16 * w + q;
    FX_LAS unsigned char* lds = F.lds;
    const FX_LAS float* ftab = (const FX_LAS float*)(lds + ATT_FTAB);
    bf16x8 qf[4];
#pragma unroll
    for (int kk = 0; kk < 4; ++kk) qf[kk] = *(const bf16x8*)((const char*)(act + qcol + h * 128) + (unsigned)(qrow * (NPAD * 2) + 64 * kk + 16 * g));
    f32x4 ot[8];
#pragma unroll
    for (int c = 0; c < 8; ++c) ot[c] = (f32x4){0.f, 0.f, 0.f, 0.f};
    float carry = 1.f, den = 0.f;
    const float a_t = FOX ? ftab[qrow] : 0.f;
    const int jmax = 2 * qb + 1, N = jmax + 1;
    const int sr = F.tid >> 4, sc = F.tid & 15;
    const char* kg = (const char*)(act + kcol + h * 128);
    const char* vg = (const char*)(act + vcol + h * 128);
    const unsigned lofs = (unsigned)((sr * NPAD + sc * 8) * 2);
    const unsigned wk0 = offK(sr, sc), wk1 = offK(sr + 32, sc), wv0 = offV(sr, sc), wv1 = offV(sr + 32, sc);
    unsigned kbase[4], vbase[8][2];
#pragma unroll
    for (int kk = 0; kk < 4; ++kk) kbase[kk] = 256u * (unsigned)(8 * (q >> 2) + (q & 3)) + 16u * ((unsigned)(4 * kk + g) ^ (unsigned)q);
#pragma unroll
    for (int c = 0; c < 8; ++c)
#pragma unroll
        for (int t = 0; t < 2; ++t) vbase[c][t] = trV16((unsigned)lane, (unsigned)c, 0u, (unsigned)t);
#define ATT_LOAD(base, n_, r0, r1) do { const char* _b = (base) + (size_t)(unsigned)__builtin_amdgcn_readfirstlane((jmax - (n_)) * (64 * NPAD * 2)); r0 = *(const u32x4*)(_b + lofs); r1 = *(const u32x4*)(_b + (size_t)(32 * NPAD * 2) + lofs); } while (0)
#define ATT_STK(slot, r0, r1) do { *(FX_LAS u32x4*)(lds + ATT_KS + (slot) * 16384u + wk0) = r0; *(FX_LAS u32x4*)(lds + ATT_KS + (slot) * 16384u + wk1) = r1; } while (0)
#define ATT_STV(slot, r0, r1) do { *(FX_LAS u32x4*)(lds + ATT_VS + (slot) * 16384u + wv0) = r0; *(FX_LAS u32x4*)(lds + ATT_VS + (slot) * 16384u + wv1) = r1; } while (0)
#define ATT_WEIGHTS(tile) do { const int _t = (tile); if (_t < 2) att_weights<FOX, true>(stc, jmax - _t, qrow, g, q, ftab, a_t, carry, den, pf); \
                                                 else        att_weights<FOX, false>(stc, jmax - _t, qrow, g, q, ftab, a_t, carry, den, pf); } while (0)
    u32x4 kr0, kr1, vr0, vr1;
    const bool roleA = ATT_NOSTAG || (w < 4);
#define ATT_ITER(n, SL, DOPV, MASKED) do { \
        if (roleA) { ATT_LOAD(kg, ((n) + 1 < N ? (n) + 1 : N - 1), kr0, kr1); ATT_LOAD(vg, (n), vr0, vr1); } \
        att_qk<ATT_KS + (SL) * 16384>(lds, kbase, qf, stc); \
        if (DOPV) att_pv<ATT_VS + (1 - (SL)) * 16384>(lds, vbase, pf, ot); \
        if (!roleA) { ATT_STK((unsigned)(1 - (SL)), kr0, kr1); ATT_STV((unsigned)(SL), vr0, vr1); } \
        ATT_BAR(); \
        if (!roleA) { ATT_LOAD(kg, ((n) + 2 < N ? (n) + 2 : N - 1), kr0, kr1); ATT_LOAD(vg, ((n) + 1 < N ? (n) + 1 : N - 1), vr0, vr1); } \
        att_weights<FOX, MASKED>(stc, jmax - (n), qrow, g, q, ftab, a_t, carry, den, pf); \
        if (roleA) { ATT_STK((unsigned)(1 - (SL)), kr0, kr1); ATT_STV((unsigned)(SL), vr0, vr1); } \
        ATT_BAR(); } while (0)
    ATT_BAR();
    ATT_LOAD(kg, 0, kr0, kr1); ATT_STK(0u, kr0, kr1);
    ATT_BAR();
    if (!roleA) { ATT_LOAD(kg, 1, kr0, kr1); ATT_LOAD(vg, 0, vr0, vr1); ATT_BAR(); }
    f32x4 stc[2][2]; bf16x8 pf[2];
    ATT_ITER(0, 0, false, true);
    ATT_ITER(1, 1, true, true);
    for (int n = 2; n < N; n += 2) { ATT_ITER(n, 0, true, false); ATT_ITER(n + 1, 1, true, false); }
    if (roleA && !ATT_NOSTAG) ATT_BAR();
    att_pv<ATT_VS + 16384>(lds, vbase, pf, ot);
#undef ATT_ITER
#undef ATT_LOAD
#undef ATT_STK
#undef ATT_STV
#undef ATT_WEIGHTS
    float inv = 1.0f;
    if (FOX) { den += shfl_xorl(den, 16, lane); den += shfl_xorl(den, 32, lane); inv = 1.0f / den; }
    char* op = (char*)(outp + h * 128); const unsigned oofs = (unsigned)((qrow * 2048 + 4 * g) * 2);
#pragma unroll
    for (int c = 0; c < 8; ++c) { u32x2 o; o.x = cvt_pk_bf16(ot[c][0] * inv, ot[c][1] * inv); o.y = cvt_pk_bf16(ot[c][2] * inv, ot[c][3] * inv); *(u32x2*)(op + 32 * c + oofs) = o; }
}

__device__ __forceinline__ void fox_ftab(const Frame& F, const float* small, const float* bfg, int h) {
    FX_LAS float* ftab = (FX_LAS float*)(F.lds + ATT_FTAB);
    FX_LAS float* wtot = (FX_LAS float*)(F.lds + ATT_FTAB + 32768);
    const float bias = bfg[h];
    int ln = F.lane; asm volatile("" : "+v"(ln));
    float v[16], run = 0.f;
#pragma unroll
    for (int k = 0; k < 16; ++k) { const float x = *(const float*)((const char*)(small + h) + (unsigned)(F.tid * 2048 + k * 128)) + bias; run += fminf(x, 0.f) - log1pf(__expf(-fabsf(x))); v[k] = run; }
    float incl = run;
#pragma unroll
    for (int o = 1; o < 64; o <<= 1) { const float t = shfl_upl(incl, o, ln); if (ln >= o) incl += t; }
    if (ln == 63) wtot[F.wave] = incl;
    __syncthreads();
    float base = incl - run;
    for (int k = 0; k < F.wave; ++k) base += wtot[k];
#pragma unroll
    for (int k = 0; k < 16; ++k) ftab[F.tid * 16 + k] = (base + v[k]) * LOG2E;
    __syncthreads();
}

__device__ __forceinline__ void phase_foxprep(const FX_CAS Args* a, const Frame& F, int l) {
    const float* gq = a->in[7] + l * 128; const float* gk = a->in[8] + l * 128;
    const int d0 = (F.lane & 15) * 8;
    float gqv[8], gkv[8];
#pragma unroll
    for (int k = 0; k < 8; ++k) { gqv[k] = gq[d0 + k] * CQK; gkv[k] = gk[d0 + k]; }
    for (int m = F.gw; m < S; m += F.NGW) {
#pragma unroll
        for (int which = 0; which < 2; ++which) {
            bf16_t* p = a->act + (size_t)m * NPAD + (which ? C_FXK : C_FXQ) + F.lane * 8;
            const u32x4 wv = *(const u32x4*)p;
            float x[8] = {bflo(wv.x), bfhi(wv.x), bflo(wv.y), bfhi(wv.y), bflo(wv.z), bfhi(wv.z), bflo(wv.w), bfhi(wv.w)};
            float ss = 0.f;
#pragma unroll
            for (int k = 0; k < 8; ++k) ss += x[k] * x[k];
            ss += shfl_xorl(ss, 1, F.lane); ss += shfl_xorl(ss, 2, F.lane); ss += shfl_xorl(ss, 4, F.lane); ss += shfl_xorl(ss, 8, F.lane);
            const float rs = rsqrtf(ss * (1.0f / 128.0f) + 1e-6f);
            u32x4 o;
            if (which) { o.x = cvt_pk_bf16(x[0] * rs * gkv[0], x[1] * rs * gkv[1]); o.y = cvt_pk_bf16(x[2] * rs * gkv[2], x[3] * rs * gkv[3]); o.z = cvt_pk_bf16(x[4] * rs * gkv[4], x[5] * rs * gkv[5]); o.w = cvt_pk_bf16(x[6] * rs * gkv[6], x[7] * rs * gkv[7]); }
            else       { o.x = cvt_pk_bf16(x[0] * rs * gqv[0], x[1] * rs * gqv[1]); o.y = cvt_pk_bf16(x[2] * rs * gqv[2], x[3] * rs * gqv[3]); o.z = cvt_pk_bf16(x[4] * rs * gqv[4], x[5] * rs * gqv[5]); o.w = cvt_pk_bf16(x[6] * rs * gqv[6], x[7] * rs * gqv[7]); }
            *(u32x4*)p = o;
        }
    }
}

__device__ __forceinline__ void phase_attn(const FX_CAS Args* a, const Frame& F, int l) {
    const int hi = blockIdx.x & 7, pi = blockIdx.x >> 3;
    for (int pr = pi; pr < 32; pr += (int)(gridDim.x >> 3)) {
        if (hi < 4) {
            attn_item<false>(F, a->act, C_SBQ, C_SBK, C_SBV, hi, 63 - pr, a->osb);
            attn_item<false>(F, a->act, C_SBQ, C_SBK, C_SBV, hi, pr, a->osb);
        } else {
            __syncthreads();
            fox_ftab(F, a->small, a->in[6] + l * 4, hi - 4);
            attn_item<true>(F, a->act, C_FXQ, C_FXK, C_FXV, hi - 4, 63 - pr, a->ofox);
            attn_item<true>(F, a->act, C_FXQ, C_FXK, C_FXV, hi - 4, pr, a->ofox);
        }
    }
    if (gridDim.x == 256) { if (hi >= 4) { ATT_BAR(); const int wf = (pi * 4 + (hi - 4)) * NWAVES + F.wave; convert_brout(a, F, l, wf, 128 * NWAVES); convert_moe(a, F, l, MOE_NA, MOE_NB, wf, 128 * NWAVES); } }
    else { ATT_BAR(); convert_brout(a, F, l, F.gw, F.NGW); }
}

constexpr int SSD_XT = 0, SSD_BT = 65536, SSD_CT = 81920, SSD_CB = 98304, SSD_DT = 114688, SSD_AC = 116736;

__device__ __forceinline__ void ssd1_item(const FX_CAS Args* a, const Frame& F, int l, int c, int grp) {
    FX_LAS unsigned char* lds = F.lds;
    FX_LAS float* dtt = (FX_LAS float*)(lds + SSD_DT); FX_LAS float* act_ = (FX_LAS float*)(lds + SSD_AC); FX_LAS float* cbm = (FX_LAS float*)(lds + SSD_CB);
    const int lane = F.lane, w = F.wave, q = lane & 15, g = lane >> 4, t0 = c * 64;
    const int h = grp * 8 + w;
    __builtin_amdgcn_sched_barrier(0); asm volatile("s_waitcnt lgkmcnt(0)" ::: "memory"); __syncthreads(); __builtin_amdgcn_sched_barrier(0);
    {
        const float x = a->small[(size_t)(t0 + lane) * 32 + 4 + h] + a->in[11][l * 16 + h];
        const float dtv = fmaxf(x, 0.f) + log1pf(__expf(-fabsf(x)));
        const float av = -__expf(a->in[12][l * 16 + h]);
        float incl = dtv * av;
#pragma unroll
        for (int o = 1; o < 64; o <<= 1) { const float t = shfl_upl(incl, o, lane); if (lane >= o) incl += t; }
        dtt[w * 64 + lane] = dtv; act_[w * 64 + lane] = incl;
        a->acum[(size_t)(t0 + lane) * 16 + h] = incl;
        if (lane == 63) a->cdec[c * 16 + h] = __expf(incl);
    }
    __syncthreads();
    {
        const float* cw = a->in[9] + (size_t)l * 4 * 1536; const float* cb = a->in[10] + (size_t)l * 1536;
#pragma unroll
        for (int pass = 0; pass < 2; ++pass) {
            if (pass == 0 || lane < 32) {
                const int ck = (pass == 0) ? lane : 64 + lane;
                const int ch = (ck < 64) ? (grp * 512 + ck * 8) : ((ck < 80) ? (1024 + grp * 128 + (ck - 64) * 8) : (1280 + grp * 128 + (ck - 80) * 8));
                u32x4 xr[11];
#pragma unroll
                for (int j = 0; j < 11; ++j) { const int tt = t0 + 8 * w - 3 + j; const u32x4 v = *(const u32x4*)(a->act + (size_t)(tt < 0 ? 0 : tt) * NPAD + C_XBC + ch); xr[j] = (tt < 0) ? (u32x4){0u, 0u, 0u, 0u} : v; }
                f32x4 wq[4][2];
#pragma unroll
                for (int wt = 0; wt < 4; ++wt) { wq[wt][0] = *(const f32x4*)(cw + wt * 1536 + ch); wq[wt][1] = *(const f32x4*)(cw + wt * 1536 + ch + 4); }
                const f32x4 b0 = *(const f32x4*)(cb + ch), b1 = *(const f32x4*)(cb + ch + 4);
#pragma unroll
                for (int tk = 0; tk < 8; ++tk) { const int lt = 8 * w + tk;
                    float acc[8];
                    acc[0] = b0[0]; acc[1] = b0[1]; acc[2] = b0[2]; acc[3] = b0[3]; acc[4] = b1[0]; acc[5] = b1[1]; acc[6] = b1[2]; acc[7] = b1[3];
#pragma unroll
                    for (int wt = 0; wt < 4; ++wt) { const u32x4 xv = xr[tk + wt]; const f32x4 w0 = wq[wt][0], w1 = wq[wt][1];
                        acc[0] += w0[0] * bflo(xv.x); acc[1] += w0[1] * bfhi(xv.x); acc[2] += w0[2] * bflo(xv.y); acc[3] += w0[3] * bfhi(xv.y);
                        acc[4] += w1[0] * bflo(xv.z); acc[5] += w1[1] * bfhi(xv.z); acc[6] += w1[2] * bflo(xv.w); acc[7] += w1[3] * bfhi(xv.w); }
                    float sc = 1.0f;
                    if (pass == 0) sc = dtt[(ck >> 3) * 64 + lt];
#pragma unroll
                    for (int k = 0; k < 8; ++k) acc[k] = silu_f(acc[k]) * sc;
                    u32x4 o; o.x = cvt_pk_bf16(acc[0], acc[1]); o.y = cvt_pk_bf16(acc[2], acc[3]); o.z = cvt_pk_bf16(acc[4], acc[5]); o.w = cvt_pk_bf16(acc[6], acc[7]);
                    if (pass == 0) *(FX_LAS u32x4*)(lds + SSD_XT + (ck >> 4) * 16384 + offV(lt, ck & 15)) = o;
                    else if (ck < 80) *(FX_LAS u32x4*)(lds + SSD_BT + offV(lt, ck - 64)) = o;
                    else { *(FX_LAS u32x4*)(lds + SSD_CT + offV(lt, ck - 80)) = o; *(u32x4*)(a->cc + (size_t)(t0 + lt) * 256 + grp * 128 + (ck - 80) * 8) = o; }
                }
            }
        }
    }
    __syncthreads();
    {
        const int mb = w >> 1;
        bf16x8 cf[4];
#pragma unroll
        for (int kk = 0; kk < 4; ++kk) cf[kk] = *(const FX_LAS bf16x8*)(lds + SSD_CT + offV(16 * mb + q, 4 * kk + g));
#pragma unroll
        for (int sbi = 0; sbi < 2; ++sbi) { const int sb = 2 * (w & 1) + sbi; f32x4 acc = (f32x4){0.f, 0.f, 0.f, 0.f};
#pragma unroll
            for (int kk = 0; kk < 4; ++kk) { const bf16x8 bfr = *(const FX_LAS bf16x8*)(lds + SSD_BT + offV(16 * sb + q, 4 * kk + g));
                acc = __builtin_amdgcn_mfma_f32_16x16x32_bf16(cf[kk], bfr, acc, 0, 0, 0); }
#pragma unroll
            for (int r = 0; r < 4; ++r) cbm[(16 * mb + 4 * g + r) * 64 + 16 * sb + q] = acc[r]; }
    }
    __syncthreads();
    const FX_LAS float* ach = act_ + w * 64; const FX_LAS float* dth = dtt + w * 64;
    FX_LAS unsigned char* xt = lds + SSD_XT + (w >> 1) * 16384;
    const int cb0 = 4 * (w & 1);
    bf16x8 xf[4][2];
#pragma unroll
    for (int pb = 0; pb < 4; ++pb)
#pragma unroll
        for (int ks = 0; ks < 2; ++ks) {
            const s16x4 v0 = __builtin_amdgcn_ds_read_tr16_b64_v4i16((FX_LAS s16x4*)(xt + trV16(lane, cb0 + pb, ks, 0)));
            const s16x4 v1 = __builtin_amdgcn_ds_read_tr16_b64_v4i16((FX_LAS s16x4*)(xt + trV16(lane, cb0 + pb, ks, 1)));
            xf[pb][ks] = __builtin_shufflevector(v0, v1, 0, 1, 2, 3, 4, 5, 6, 7); }
    {
        const float dsk = a->in[13][l * 16 + h];
#pragma unroll 1
        for (int mb = 0; mb < 4; ++mb) { const int lr = 16 * mb + q; const float al = ach[lr];
            f32x4 yd[4];
#pragma unroll
            for (int nb = 0; nb < 4; ++nb) yd[nb] = (f32x4){0.f, 0.f, 0.f, 0.f};
#pragma unroll
            for (int ks = 0; ks < 2; ++ks) { const int s0 = 32 * ks + 8 * g;
                const f32x4 c0 = *(const FX_LAS f32x4*)(cbm + lr * 64 + s0), c1 = *(const FX_LAS f32x4*)(cbm + lr * 64 + s0 + 4);
                const f32x4 a0 = *(const FX_LAS f32x4*)(ach + s0), a1 = *(const FX_LAS f32x4*)(ach + s0 + 4);
                float mv[8];
#pragma unroll
                for (int jj = 0; jj < 8; ++jj) { const float cbv = (jj < 4) ? c0[jj & 3] : c1[jj & 3], as = (jj < 4) ? a0[jj & 3] : a1[jj & 3];
                    mv[jj] = (s0 + jj <= lr) ? cbv * __expf(al - as) : 0.f; }
                u32x4 mw; mw.x = cvt_pk_bf16(mv[0], mv[1]); mw.y = cvt_pk_bf16(mv[2], mv[3]); mw.z = cvt_pk_bf16(mv[4], mv[5]); mw.w = cvt_pk_bf16(mv[6], mv[7]);
                const bf16x8 mf = __builtin_bit_cast(bf16x8, mw);
#pragma unroll
                for (int nb = 0; nb < 4; ++nb) yd[nb] = __builtin_amdgcn_mfma_f32_16x16x32_bf16(xf[nb][ks], mf, yd[nb], 0, 0, 0); }
            { const float sk = dsk / dth[lr];
#pragma unroll
                for (int nb = 0; nb < 4; ++nb) { const int col = 64 * (w & 1) + 16 * nb + 4 * g;
                    const u32x2 xw = *(const FX_LAS u32x2*)(xt + offV(lr, col >> 3) + (col & 7) * 2);
                    u32x2 o; o.x = cvt_pk_bf16(yd[nb][0] + sk * bflo(xw.x), yd[nb][1] + sk * bfhi(xw.x)); o.y = cvt_pk_bf16(yd[nb][2] + sk * bflo(xw.y), yd[nb][3] + sk * bfhi(xw.y));
                    *(u32x2*)(a->y1 + (size_t)(t0 + lr) * 1024 + h * 64 + 16 * nb + 4 * g) = o; } }
        }
    }
    {
        const float aend = ach[63];
#pragma unroll
        for (int ks = 0; ks < 2; ++ks) { const int l0 = 32 * ks + 8 * g;
            const f32x4 a0 = *(const FX_LAS f32x4*)(ach + l0), a1 = *(const FX_LAS f32x4*)(ach + l0 + 4);
            float de[8];
#pragma unroll
            for (int jj = 0; jj < 8; ++jj) de[jj] = __expf(aend - ((jj < 4) ? a0[jj & 3] : a1[jj & 3]));
#pragma unroll
            for (int pb = 0; pb < 4; ++pb) { const u32x4 xw = __builtin_bit_cast(u32x4, xf[pb][ks]); u32x4 o;
                o.x = cvt_pk_bf16(bflo(xw.x) * de[0], bfhi(xw.x) * de[1]); o.y = cvt_pk_bf16(bflo(xw.y) * de[2], bfhi(xw.y) * de[3]);
                o.z = cvt_pk_bf16(bflo(xw.z) * de[4], bfhi(xw.z) * de[5]); o.w = cvt_pk_bf16(bflo(xw.w) * de[6], bfhi(xw.w) * de[7]);
                xf[pb][ks] = __builtin_bit_cast(bf16x8, o); } }
        bf16_t* stp = a->states + ((size_t)c * 16 + h) * 64 * 128;
#pragma unroll 1
        for (int nbg = 0; nbg < 8; ++nbg) {
            f32x4 sa[4];
#pragma unroll
            for (int pb = 0; pb < 4; ++pb) sa[pb] = (f32x4){0.f, 0.f, 0.f, 0.f};
#pragma unroll
            for (int ks = 0; ks < 2; ++ks) {
                const s16x4 v0 = __builtin_amdgcn_ds_read_tr16_b64_v4i16((FX_LAS s16x4*)(lds + SSD_BT + trV16(lane, nbg, ks, 0)));
                const s16x4 v1 = __builtin_amdgcn_ds_read_tr16_b64_v4i16((FX_LAS s16x4*)(lds + SSD_BT + trV16(lane, nbg, ks, 1)));
                const bf16x8 bfr = __builtin_shufflevector(v0, v1, 0, 1, 2, 3, 4, 5, 6, 7);
#pragma unroll
                for (int pb = 0; pb < 4; ++pb) sa[pb] = __builtin_amdgcn_mfma_f32_16x16x32_bf16(bfr, xf[pb][ks], sa[pb], 0, 0, 0); }
#pragma unroll
            for (int pb = 0; pb < 4; ++pb) { u32x2 o; o.x = cvt_pk_bf16(sa[pb][0], sa[pb][1]); o.y = cvt_pk_bf16(sa[pb][2], sa[pb][3]);
                *(u32x2*)(stp + (size_t)(16 * pb + q) * 128 + 16 * nbg + 4 * g) = o; }
        }
    }
}
__device__ __forceinline__ void phase_ssd1(const FX_CAS Args* a, const Frame& F, int l) {
    for (int it = blockIdx.x; it < 256; it += gridDim.x) ssd1_item(a, F, l, it >> 1, it & 1);
}
__device__ __forceinline__ void phase_ssdscan(const FX_CAS Args* a, const Frame& F) {
    for (int idx = blockIdx.x * NTHR + F.tid; idx < 16 * 64 * 128; idx += gridDim.x * NTHR) {
        const int h = __builtin_amdgcn_readfirstlane(idx >> 13); float run = 0.f;
#pragma unroll 1
        for (int c0 = 0; c0 < 128; c0 += 16) {
            float sv[16], dv[16];
#pragma unroll
            for (int k = 0; k < 16; ++k) { sv[k] = bf2f(a->states[(size_t)(c0 + k) * 131072 + idx]); dv[k] = a->cdec[(c0 + k) * 16 + h]; }
#pragma unroll
            for (int k = 0; k < 16; ++k) { a->hin[(size_t)(c0 + k) * 131072 + idx] = (bf16_t)(cvt_pk_bf16(run, 0.f) & 0xffffu); run = run * dv[k] + sv[k]; }
        }
    }
}
__device__ __forceinline__ void ssd3_item(const FX_CAS Args* a, const Frame& F, int l, int it) {
    FX_LAS float* red = (FX_LAS float*)(F.lds);
    const int lane = F.lane, w = F.wave, q = lane & 15, g = lane >> 4;
    const int c = it >> 1;
    const float* gn = a->in[14] + l * 1024;
#pragma unroll 1
    for (int mb = 0; mb < 2; ++mb) {
        const int t0 = 64 * c + 32 * (it & 1) + 16 * mb;
        float v[2][4][4];
        float ss[4];
#pragma unroll
        for (int r = 0; r < 4; ++r) ss[r] = 0.f;
#pragma unroll
        for (int hh = 0; hh < 2; ++hh) {
            const int h = 2 * w + hh, grp = h >> 3;
            const char* hp = (const char*)(a->hin + ((size_t)c * 16 + h) * 64 * 128);
            const char* cp = (const char*)(a->cc + (size_t)t0 * 256 + grp * 128);
            const unsigned hlo = (unsigned)(q * 256 + g * 16), clo = (unsigned)(q * 512 + g * 16);
            f32x4 acc[4];
#pragma unroll
            for (int nb = 0; nb < 4; ++nb) acc[nb] = (f32x4){0.f, 0.f, 0.f, 0.f};
#pragma unroll
            for (int kk = 0; kk < 4; ++kk) {
                const bf16x8 cf = *(const bf16x8*)(cp + kk * 64 + clo);
#pragma unroll
                for (int nb = 0; nb < 4; ++nb) { const bf16x8 hf = *(const bf16x8*)(hp + nb * 4096 + kk * 64 + hlo);
                    acc[nb] = __builtin_amdgcn_mfma_f32_16x16x32_bf16(cf, hf, acc[nb], 0, 0, 0); }
            }
#pragma unroll
            for (int r = 0; r < 4; ++r) { const size_t t = (size_t)(t0 + 4 * g + r); const float ea = __expf(a->acum[t * 16 + h]);
#pragma unroll
                for (int nb = 0; nb < 4; ++nb) { const int ch = h * 64 + 16 * nb + q;
                    const float y = acc[nb][r] * ea + bf2f(a->y1[t * 1024 + ch]);
                    const float z = bf2f(a->act[t * NPAD + C_Z + ch]);
                    const float vv = y * silu_f(z); v[hh][nb][r] = vv; ss[r] += vv * vv; } }
        }
#pragma unroll
        for (int r = 0; r < 4; ++r) { float s = ss[r]; s += shfl_xorl(s, 1, lane); s += shfl_xorl(s, 2, lane); s += shfl_xorl(s, 4, lane); s += shfl_xorl(s, 8, lane); ss[r] = s; }
        __syncthreads();
        if (q == 0) {
#pragma unroll
            for (int r = 0; r < 4; ++r) red[w * 16 + 4 * g + r] = ss[r];
        }
        __syncthreads();
#pragma unroll
        for (int r = 0; r < 4; ++r) { const int tl = 4 * g + r; float tot = 0.f;
#pragma unroll
            for (int k = 0; k < 8; ++k) tot += red[k * 16 + tl];
            const float rs = rsqrtf(tot * (1.0f / 1024.0f) + 1e-6f);
#pragma unroll
            for (int hh = 0; hh < 2; ++hh)
#pragma unroll
                for (int nb = 0; nb < 4; ++nb) { const int ch = (2 * w + hh) * 64 + 16 * nb + q;
                    a->ossm[(size_t)(t0 + tl) * 2048 + ch] = (bf16_t)(cvt_pk_bf16(v[hh][nb][r] * rs * gn[ch], 0.f) & 0xffffu); } }
    }
}
__device__ __forceinline__ void phase_ssd3(const FX_CAS Args* a, const Frame& F, int l) {
    for (int it = blockIdx.x; it < 256; it += gridDim.x) ssd3_item(a, F, l, it);
}

__device__ __forceinline__ unsigned wr_off(int d, int q4) { const int r = d >> 2; return (unsigned)(((d & 3) * 512 + r) * 64 + 16 * (q4 ^ ((r >> 2) & 3))); }
constexpr int MOE_CNT = LDS_MISC + 64;

__device__ __forceinline__ void router_c0(const FX_CAS Args* a, const Frame& F, int l) {
    if (F.gw != 0) return;
    const float* shift = a->mod + (size_t)l * 6 * D + 3 * D;
    float acc[16];
#pragma unroll
    for (int e = 0; e < 16; ++e) acc[e] = 0.f;
#pragma unroll 8
    for (int d = F.lane; d < D; d += 64) { const float sh = shift[d]; const f32x4* wr = (const f32x4*)(a->in[20] + (size_t)d * 16);
#pragma unroll
        for (int q4 = 0; q4 < 4; ++q4) { const f32x4 wv = wr[q4]; acc[4 * q4] += sh * wv[0]; acc[4 * q4 + 1] += sh * wv[1]; acc[4 * q4 + 2] += sh * wv[2]; acc[4 * q4 + 3] += sh * wv[3]; } }
#pragma unroll
    for (int e = 0; e < 16; ++e) { const float t = wave_sum(acc[e]); if (F.lane == 0) a->c0[l * 16 + e] = t; }
}
constexpr int MOE_LG = LDS_MISC + 512;

template <bool XBF>
__device__ __forceinline__ void phase_router(const FX_CAS Args* a, const Frame& F, int l) {
    FX_LAS unsigned char* lds = F.lds;
    FX_LAS int* cnt = (FX_LAS int*)(lds + MOE_CNT);
    FX_LAS float* lg = (FX_LAS float*)(lds + MOE_LG) + F.wave * 64;
    const float* mod = a->mod + (size_t)l * 6 * D;
    const float* gain = a->in[19] + l * D; const float* scale = mod + 4 * D; const float* shift = mod + 3 * D;
    __syncthreads();
#pragma unroll 16
    for (int i = F.tid; i < D * 4; i += NTHR) { const int d = i >> 2, q4 = i & 3; *(FX_LAS f32x4*)(lds + wr_off(d, q4)) = *(const f32x4*)(a->in[20] + (size_t)d * 16 + q4 * 4); }
    if (F.tid < 16) cnt[F.tid] = 0;
    __syncthreads();
    const unsigned wbase = (unsigned)(F.lane * 64), wsw = (unsigned)((F.lane >> 2) & 3);
    const int lane = F.lane;
    for (int blk = blockIdx.x; blk < S / 32; blk += gridDim.x) {
        const int m0 = blk * 32 + F.wave * 4;
        const f32x4* xr = (const f32x4*)(a->in[0] + (size_t)m0 * D) + lane;
        const u32x2* xb = (const u32x2*)(a->xbuf + (size_t)m0 * D) + lane;
#define RT_LOADX(dst, idx) do { if (XBF) { const u32x2 _v = xb[idx]; dst = (f32x4){bflo(_v.x), bfhi(_v.x), bflo(_v.y), bfhi(_v.y)}; } else dst = xr[idx]; } while (0)
        const u32x2* dr = (const u32x2*)(a->osb + (size_t)m0 * D) + lane;
        float acc[64], ss[4];
#pragma unroll
        for (int i = 0; i < 64; ++i) acc[i] = 0.f;
#pragma unroll
        for (int r = 0; r < 4; ++r) ss[r] = 0.f;
#pragma unroll 1
        for (int j = 0; j < 8; ++j) {
            const f32x4 gg = ((const f32x4*)gain)[lane + 64 * j], sc = ((const f32x4*)scale)[lane + 64 * j];
            f32x4 x[4];
#pragma unroll
            for (int r = 0; r < 4; ++r) { RT_LOADX(x[r], r * (D / 4) + 64 * j); { const u32x2 dv = dr[r * (D / 4) + 64 * j]; x[r][0] += bflo(dv.x); x[r][1] += bfhi(dv.x); x[r][2] += bflo(dv.y); x[r][3] += bfhi(dv.y); } ss[r] += (x[r][0] * x[r][0] + x[r][1] * x[r][1]) + (x[r][2] * x[r][2] + x[r][3] * x[r][3]); }
#pragma unroll
            for (int k = 0; k < 4; ++k) { const float G = gg[k] * (1.0f + sc[k]);
#pragma unroll
                for (int q4 = 0; q4 < 4; ++q4) { const f32x4 wv = *(const FX_LAS f32x4*)(lds + k * 32768 + j * 4096 + wbase + 16u * ((unsigned)q4 ^ wsw));
#pragma unroll
                    for (int r = 0; r < 4; ++r) { const float u = x[r][k] * G;
                        acc[r * 16 + 4 * q4 + 0] += u * wv[0]; acc[r * 16 + 4 * q4 + 1] += u * wv[1]; acc[r * 16 + 4 * q4 + 2] += u * wv[2]; acc[r * 16 + 4 * q4 + 3] += u * wv[3]; } } }
        }
        float rs[4];
#pragma unroll
        for (int r = 0; r < 4; ++r) rs[r] = rsqrtf(wave_sum(ss[r]) * (1.0f / D) + 1e-6f);
#pragma unroll 1
        for (int j = 0; j < 8; ++j) {
            const f32x4 gg = ((const f32x4*)gain)[lane + 64 * j], sc = ((const f32x4*)scale)[lane + 64 * j], sh = ((const f32x4*)shift)[lane + 64 * j];
#pragma unroll
            for (int r = 0; r < 4; ++r) { f32x4 x; RT_LOADX(x, r * (D / 4) + 64 * j); { const u32x2 dv = dr[r * (D / 4) + 64 * j]; x[0] += bflo(dv.x); x[1] += bfhi(dv.x); x[2] += bflo(dv.y); x[3] += bfhi(dv.y); } float h[4];
#pragma unroll
                for (int k = 0; k < 4; ++k) h[k] = x[k] * rs[r] * (gg[k] * (1.0f + sc[k])) + sh[k];
                u32x2 wv; wv.x = cvt_pk_bf16(h[0], h[1]); wv.y = cvt_pk_bf16(h[2], h[3]);
                ((u32x2*)(a->hb + (size_t)(m0 + r) * D))[lane + 64 * j] = wv; }
        }
        {
            const int ln = fx_lane();
#pragma unroll
            for (int m = 32, n = 64; m >= 1; m >>= 1, n >>= 1) { const bool hi = (ln & m) != 0;
#pragma unroll
                for (int i = 0; i < 32; ++i) if (i < n / 2) { const float snd = hi ? acc[i] : acc[i + n / 2], kp = hi ? acc[i + n / 2] : acc[i]; acc[i] = kp + shfl_xorl(snd, m, ln); } }
            const int rr = ln >> 4; const float rsel = (rr == 0) ? rs[0] : ((rr == 1) ? rs[1] : ((rr == 2) ? rs[2] : rs[3]));
            lg[ln] = acc[0] * rsel + a->c0[l * 16 + (ln & 15)];
        }
        asm volatile("s_waitcnt lgkmcnt(0)" ::: "memory");
        if (lane < 4) {
            const int r = lane; float aff[16], sel[16];
#pragma unroll
            for (int e = 0; e < 16; ++e) { const float v = lg[r * 16 + e]; aff[e] = 1.0f / (1.0f + __expf(-v)); sel[e] = aff[e] + a->in[21][e]; }
            int bg = 0; float bs = -1e30f;
#pragma unroll
            for (int gI = 0; gI < 4; ++gI) { float m1 = -1e30f, m2 = -1e30f;
#pragma unroll
                for (int jx = 0; jx < 4; ++jx) { const float v = sel[gI * 4 + jx]; if (v > m1) { m2 = m1; m1 = v; } else if (v > m2) m2 = v; }
                const float sc2 = m1 + m2; if (sc2 > bs) { bs = sc2; bg = gI; } }
            int i1 = 0, i2 = 0; float m1 = -1e30f, m2 = -1e30f, a1 = 0.f, a2 = 0.f;
#pragma unroll
            for (int e = 0; e < 16; ++e) { if ((e >> 2) == bg) { const float v = sel[e];
                    if (v > m1) { m2 = m1; i2 = i1; a2 = a1; m1 = v; i1 = e; a1 = aff[e]; } else if (v > m2) { m2 = v; i2 = e; a2 = aff[e]; } } }
            const int m = m0 + r; const float inv = 1.0f / (a1 + a2);
            a->eidx[m * 2] = i1; a->eidx[m * 2 + 1] = i2; a->wsel[m * 2] = a1 * inv; a->wsel[m * 2 + 1] = a2 * inv;
            __hip_atomic_fetch_add((int*)(cnt + i1), 1, __ATOMIC_RELAXED, __HIP_MEMORY_SCOPE_WORKGROUP); __hip_atomic_fetch_add((int*)(cnt + i2), 1, __ATOMIC_RELAXED, __HIP_MEMORY_SCOPE_WORKGROUP);
        }
        __syncthreads();
        if (F.tid < 16) { a->cntb[blk * 16 + F.tid] = cnt[F.tid]; cnt[F.tid] = 0; }
        __syncthreads();
    }
}
#undef RT_LOADX
__device__ __forceinline__ void phase_lists(const FX_CAS Args* a, const Frame& F) {
    FX_LAS int* tot = (FX_LAS int*)(F.lds + MOE_CNT); FX_LAS int* pre = tot + 16; FX_LAS int* base = tot + 32;
    FX_LAS int* ev = (FX_LAS int*)(F.lds);
    for (int blk = blockIdx.x; blk < S / 32; blk += gridDim.x) {
        __syncthreads();
        if (F.tid < 32) tot[F.tid] = 0;
        if (F.tid < 64) ev[F.tid] = a->eidx[blk * 64 + F.tid];
        __syncthreads();
        {
            const int ln = fx_lane(); int t = 0, p = 0;
#pragma unroll
            for (int k = 0; k < (S / 32) / 32; ++k) { const int cv = a->cntb[F.tid + 512 * k]; t += cv; p += (((F.tid >> 4) + 32 * k) < blk) ? cv : 0; }
            t += __builtin_amdgcn_ds_bpermute((ln ^ 16) << 2, t); p += __builtin_amdgcn_ds_bpermute((ln ^ 16) << 2, p); t += __builtin_amdgcn_ds_bpermute((ln ^ 32) << 2, t); p += __builtin_amdgcn_ds_bpermute((ln ^ 32) << 2, p);
            if (ln < 16) { __hip_atomic_fetch_add((int*)(tot + ln), t, __ATOMIC_RELAXED, __HIP_MEMORY_SCOPE_WORKGROUP); __hip_atomic_fetch_add((int*)(pre + ln), p, __ATOMIC_RELAXED, __HIP_MEMORY_SCOPE_WORKGROUP); }
        }
        __syncthreads();
        if (F.tid == 0) { int tb = 0; for (int e = 0; e < 16; ++e) { base[e] = tb * 256; if (blk == 0) a->tbase[e] = tb; tb += (tot[e] + 255) >> 8; } if (blk == 0) a->tbase[16] = tb; }
        __syncthreads();
        if (F.tid < 64) { const int i = F.tid, e = ev[i]; int rank = 0;
#pragma unroll
            for (int q = 0; q < NE; ++q) { const unsigned long long mk = __builtin_amdgcn_ballot_w64(e == q); const int below = (int)__builtin_amdgcn_mbcnt_hi((unsigned)(mk >> 32), __builtin_amdgcn_mbcnt_lo((unsigned)mk, 0u)); if (e == q) rank = below; }
            const int pos = base[e] + pre[e] + rank, m = blk * 32 + (i >> 1); a->slot[m * 2 + (i & 1)] = pos; a->list[pos] = m; }
        if (blk < 16) { const int e = blk; const int n = tot[e], cap = ((n + 255) >> 8) * 256; for (int i = n + F.tid; i < cap; i += NTHR) a->list[base[e] + i] = 0; }
    }
}
constexpr int MOE_DEP = 131072;
__device__ __forceinline__ void phase_gateup(const FX_CAS Args* a, const Frame& F, int l) {
    Gemm g{a->hb, a->w_gu_t + (size_t)l * NE * D * D, D, (size_t)D * D * 2, a->list, a->ctl + MOE_DEP + l * 128}; MoeOrder Mo{a->tbase, F.G, (int)blockIdx.x, D / BK};
    EpiGateUp E{a->actb};
    gemm_phase<EpiGateUp, MoeOrder, true, 1>(F.lds, F.tid, g, Mo, E);
}
__device__ __forceinline__ void phase_down(const FX_CAS Args* a, const Frame& F, int l) {
    Gemm g{a->actb, a->w_d_t + (size_t)l * NE * D * FF, FF, (size_t)D * FF * 2, nullptr, a->ctl + MOE_DEP + l * 128}; DownOrder Mo{a->tbase, F.G, (int)blockIdx.x, FF / BK};
    EpiDown E{a->ybuf};
    gemm_phase<EpiDown, DownOrder, false, 2>(F.lds, F.tid, g, Mo, E);
}
#ifndef DUP_PRO
#define DUP_PRO 0
#endif
#ifndef DUP_INPROJ
#define DUP_INPROJ 0
#endif
#ifndef DUP_ATTN
#define DUP_ATTN 0
#endif
#ifndef DUP_MOE
#define DUP_MOE 0
#endif
#ifndef DUP_BRANCH
#define DUP_BRANCH 0
#endif
#ifndef DUP_SSD
#define DUP_SSD 0
#endif
#ifndef DUP_ROUTER
#define DUP_ROUTER 0
#endif
#ifndef DUP_THIN
#define DUP_THIN 0
#endif

enum { PH_PRO = 0, PH_NORMA = 1, PH_INPROJ = 2, PH_BRANCH = 3, PH_OUT = 4, PH_FOXPREP = 5, PH_ATTN = 6, PH_SSD1 = 7, PH_SSDSCAN = 8, PH_SSD3 = 9,
       PH_ROUTER = 10, PH_LISTS = 11, PH_GATEUP = 12, PH_DOWN = 13, PH_NORMC = 14, PH_FINAL = 15 };

__device__ __forceinline__ Frame make_frame(unsigned char* lds) {
    Frame F; F.lds = (FX_LAS unsigned char*)lds; F.tid = threadIdx.x; F.lane = F.tid & 63; F.wave = __builtin_amdgcn_readfirstlane(F.tid >> 6);
    F.G = gridDim.x; F.gw = blockIdx.x * NWAVES + F.wave; F.NGW = F.G * NWAVES; return F;
}
template <int PH>
__device__ __forceinline__ void run_phase(const FX_CAS Args* a0, const Frame& F0, int l) {
    Frame F = F0; F.lane = (int)__builtin_amdgcn_mbcnt_hi(~0u, __builtin_amdgcn_mbcnt_lo(~0u, 0u)); asm volatile("" : "+v"(F.lane)); F.tid = F.wave * 64 + F.lane;
    const FX_CAS Args* a = a0; asm volatile("" : "+s"(a));
    const float* mod = a->mod + (size_t)l * 6 * D;
    if constexpr (PH == PH_PRO) phase_prologue(a, F);
    if constexpr (PH == PH_NORMA || PH == PH_NORMC) router_c0(a, F, l);
    if constexpr (PH == PH_NORMA) phase_normmod<false, true>(F, a->in[0], nullptr, nullptr, nullptr, nullptr, nullptr, nullptr, a->in[4] + l * D, mod + D, mod, a->hb);
    if constexpr (PH == PH_NORMC) phase_normmod<true, true, false, true>(F, a->in[0], a->xbuf, mod - D, a->ybuf, a->slot, a->wsel, a->osb, a->in[4] + l * D, mod + D, mod, a->hb);
    if constexpr (PH == PH_NORMC) convert_in1(a, F);
    if constexpr (PH == PH_FINAL) phase_normmod<true, false, true, false>(F, a->xbuf, a->out, mod + 5 * D, a->ybuf, a->slot, a->wsel, a->osb, nullptr, nullptr, nullptr, nullptr);
    if constexpr (PH == PH_INPROJ) {
        Gemm g{a->hb, a->w_in_t + (size_t)l * NPAD * D, D, 0, nullptr}; StaticOrder So; So.init(S, NPAD, D, F.G, (int)blockIdx.x);
        EpiInProj E{a->act, a->small};
        gemm_phase<EpiInProj, StaticOrder, false>(F.lds, F.tid, g, So, E);
        if (gridDim.x == 256 && blockIdx.x >= 224) convert_moe(a, F, l, 0, MOE_NA, (int)(blockIdx.x - 224) * NWAVES + F.wave, 32 * NWAVES);
    }
    if constexpr (PH == PH_BRANCH) phase_branch(a, F, l);
    if constexpr (PH == PH_OUT) phase_out(a, F, l);
    if constexpr (PH == PH_FOXPREP) phase_foxprep(a, F, l);
    if constexpr (PH == PH_ATTN) phase_attn(a, F, l);
    if constexpr (PH == PH_SSD1) phase_ssd1(a, F, l);
    if constexpr (PH == PH_SSDSCAN) phase_ssdscan(a, F);
    if constexpr (PH == PH_SSD3) phase_ssd3(a, F, l);
    if constexpr (PH == PH_ROUTER) { if (l == 0) phase_router<false>(a, F, l); else phase_router<true>(a, F, l); }
    if constexpr (PH == PH_LISTS) phase_lists(a, F);
    if constexpr (PH == PH_GATEUP) phase_gateup(a, F, l);
    if constexpr (PH == PH_DOWN) phase_down(a, F, l);
}
__global__ void __launch_bounds__(NTHR, 2) mega_fwd(Args a_unused) {
    extern __shared__ __attribute__((aligned(16))) unsigned char lds_raw[];
    const Frame F = make_frame(lds_raw);
    const FX_CAS Args* a = (const FX_CAS Args*)__builtin_amdgcn_kernarg_segment_ptr();
    volatile FX_LAS unsigned* misc = (volatile FX_LAS unsigned*)(F.lds + LDS_MISC);
    if (F.tid < 64) misc[F.tid] = 0u;
    __syncthreads();
    const XcdBarrier bar = xcd_barrier_post(a->ctl + 4096, misc, F.wave);
    run_phase<PH_PRO>(a, F, 0);
    xcd_barrier(bar);
    if (DUP_PRO) { run_phase<PH_PRO>(a, F, 0); xcd_barrier(bar); }
#define FX_LAYER(l, NORMPH) do { \
        run_phase<NORMPH>(a, F, l); xcd_barrier(bar); \
        run_phase<PH_INPROJ>(a, F, l); xcd_barrier(bar); \
        if (DUP_INPROJ) { run_phase<PH_INPROJ>(a, F, l); xcd_barrier(bar); } \
        run_phase<PH_FOXPREP>(a, F, l); run_phase<PH_SSD1>(a, F, l); xcd_barrier(bar); \
        if (DUP_SSD) { run_phase<PH_SSD1>(a, F, l); xcd_barrier(bar); } \
        run_phase<PH_SSDSCAN>(a, F, l); xcd_barrier(bar); \
        if (DUP_SSD) { run_phase<PH_SSDSCAN>(a, F, l); xcd_barrier(bar); run_phase<PH_SSD3>(a, F, l); xcd_barrier(bar); } \
        run_phase<PH_SSD3>(a, F, l); run_phase<PH_ATTN>(a, F, l); xcd_barrier(bar); \
        if (DUP_ATTN) { run_phase<PH_ATTN>(a, F, l); xcd_barrier(bar); } \
        run_phase<PH_BRANCH>(a, F, l); xcd_barrier(bar); \
        if (DUP_BRANCH) { run_phase<PH_BRANCH>(a, F, l); xcd_barrier(bar); } \
        run_phase<PH_OUT>(a, F, l); xcd_barrier(bar); \
        run_phase<PH_ROUTER>(a, F, l); xcd_barrier(bar); \
        run_phase<PH_LISTS>(a, F, l); xcd_barrier(bar); \
        if (DUP_ROUTER) { run_phase<PH_ROUTER>(a, F, l); xcd_barrier(bar); run_phase<PH_LISTS>(a, F, l); xcd_barrier(bar); } \
        run_phase<PH_GATEUP>(a, F, l); \
        run_phase<PH_DOWN>(a, F, l); xcd_barrier(bar); \
        } while (0)
    FX_LAYER(0, PH_NORMA);
    FX_LAYER(1, PH_NORMC);
#undef FX_LAYER
    if (DUP_THIN) { for (int i = 0; i < 10; ++i) xcd_barrier(bar); }
    run_phase<PH_FINAL>(a, F, 1);
}
static bool carve(Args& a, void* const* d_in, void* d_out, void* d_ws, size_t ws_size) {
    for (int i = 0; i < 25; ++i) a.in[i] = (const float*)d_in[i];
    a.out = (float*)d_out;
    unsigned char* ws = (unsigned char*)d_ws; size_t o = 0;
    auto take = [&](size_t bytes) { unsigned char* p = ws + o; o += (bytes + 255) & ~(size_t)255; return p; };
    a.ctl = (unsigned*)take(1 << 20);
    a.mod = (float*)take(2 * 6 * D * 4);
    a.w_in_t = (bf16_t*)take((size_t)2 * NPAD * D * 2);
    a.w_br_t = (bf16_t*)take((size_t)2 * D * D * 2); a.w_out_t = (bf16_t*)take((size_t)2 * D * D * 2);
    a.w_gu_t = (bf16_t*)take((size_t)2 * NE * D * D * 2); a.w_d_t = (bf16_t*)take((size_t)2 * NE * D * FF * 2);
    a.act = (bf16_t*)take((size_t)S * NPAD * 2);
    a.small = (float*)take((size_t)S * 32 * 4);
    a.hb = (bf16_t*)take((size_t)S * D * 2);
    a.osb = (bf16_t*)take((size_t)S * 2048 * 2); a.ofox = a.osb + 512; a.ossm = a.osb + 1024;
    a.merged = (bf16_t*)take((size_t)S * D * 2);
    a.xbuf = (bf16_t*)take((size_t)S * D * 2);
    a.states = (bf16_t*)take((size_t)128 * 131072 * 2); a.hin = (bf16_t*)take((size_t)128 * 131072 * 2); a.y1 = (bf16_t*)take((size_t)S * 1024 * 2);
    a.cc = (bf16_t*)take((size_t)S * 256 * 2); a.acum = (float*)take((size_t)S * 16 * 4); a.cdec = (float*)take(128 * 16 * 4);
    a.eidx = (int*)take((size_t)S * 2 * 4); a.wsel = (float*)take((size_t)S * 2 * 4); a.slot = (int*)take((size_t)S * 2 * 4); a.list = (int*)take((size_t)SLOTCAP * 4);
    a.cntb = (int*)take(256 * 16 * 4); a.tbase = (int*)take(256); a.c0 = (float*)take(256);
    a.actb = (bf16_t*)take((size_t)SLOTCAP * FF * 2); a.ybuf = (bf16_t*)take((size_t)SLOTCAP * D * 2);
    return o <= ws_size;
}
}

extern "C" void kernel_launch(void* const* d_in, const int* in_sizes, int n_in, void* d_out, int out_size, void* d_ws, size_t ws_size, hipStream_t stream) {
    (void)in_sizes; (void)n_in; (void)out_size;
    static int grid = 0;
    if (grid == 0) {
        int dev = 0, cus = 0;
        if (hipGetDevice(&dev) != hipSuccess || hipDeviceGetAttribute(&cus, hipDeviceAttributeMultiprocessorCount, dev) != hipSuccess) { grid = -1; return; }
        if (hipFuncSetAttribute((const void*)fx::mega_fwd, hipFuncAttributeMaxDynamicSharedMemorySize, fx::LDS_BYTES) != hipSuccess) { grid = -1; return; }
        grid = cus > 256 ? 256 : cus;
    }
    if (grid < 0) return;
    fx::Args a{};
    if (!fx::carve(a, d_in, d_out, d_ws, ws_size)) return;
    (void)hipMemsetAsync(a.ctl, 0, 1 << 20, stream);
    hipLaunchKernelGGL(fx::mega_fwd, dim3(grid), dim3(fx::NTHR), fx::LDS_BYTES, stream, a);
}
```
